# Optimizing an MI355X kernel written in HIP

```python
import jax, jax.numpy as jnp
from jax import lax
import numpy as np

D_MODEL = 1024
BATCH = 32
SEQ = 256
DEPTH = 4
DEC_BATCH = 2
DEC_SEQ = 4096
PAST_LEN = 512

GRID_W = 64
N_MIXERS = 3
N_ATTN_LAYERS = (DEPTH + 2) // 3
N_RWKV_LAYERS = (DEPTH + 1) // 3
N_POOL_LAYERS = DEPTH // 3
MLA_HEADS = 16
Q_LORA_RANK = 384
KV_LORA_RANK = 256
QK_NOPE_DIM = 64
QK_ROPE_DIM = 32
V_HEAD_DIM = 64
ROPE_THETA = 10000.0
Q_BLOCK = 128
RWKV_HEAD = 64
RWKV_HEADS = D_MODEL // RWKV_HEAD
DECAY_LORA = 64
AAA_LORA = 64
GATE_LORA = 128
RWKV_GN_EPS = 64e-5
POOL_WINDOWS = (2, 4, 8, 16)
POOL_GROUP = D_MODEL // len(POOL_WINDOWS)
D_FF = -(-8 * D_MODEL // (3 * 256)) * 256
ALPHA = (2 * DEPTH) ** 0.25
BETA = (8 * DEPTH) ** -0.25
LN_EPS = 1e-5
RMS_EPS = 1e-6

kernel_name = 'hybrid_mla_rwkv7_pool_diffusion_step'


def layer_norm(x, g, b):
    xf = x.astype(jnp.float32)
    mu = xf.mean(-1, keepdims=True)
    var = jnp.square(xf - mu).mean(-1, keepdims=True)
    return ((xf - mu) * lax.rsqrt(var + LN_EPS) * g + b).astype(x.dtype)


def rms_norm(x, g):
    xf = x.astype(jnp.float32)
    return (xf * lax.rsqrt(jnp.square(xf).mean(-1, keepdims=True) + RMS_EPS) * g).astype(x.dtype)


def adaln(cond, w, b):
    m = (jax.nn.silu(cond) @ w + b)[..., None, :]
    return jnp.split(m, 6, axis=-1)


def modulate(x, shift, scale):
    return x * (1.0 + scale) + shift


def swiglu(h, wg, wu, wd):
    return (jax.nn.silu(h @ wg) * (h @ wu)) @ wd


def axial_rope(n_tokens, dtype):
    rows = n_tokens // GRID_W
    row = jnp.repeat(jnp.arange(rows, dtype=jnp.float32), GRID_W)
    col = jnp.tile(jnp.arange(GRID_W, dtype=jnp.float32), rows)
    n_freq = QK_ROPE_DIM // 4
    inv_freq = ROPE_THETA ** (-jnp.arange(n_freq, dtype=jnp.float32) / n_freq)
    ang = jnp.stack([row[:, None] * inv_freq, col[:, None] * inv_freq], axis=1)
    return jnp.cos(ang).astype(dtype), jnp.sin(ang).astype(dtype)


def rope_2d(x, cos, sin):
    xs = x.reshape(*x.shape[:-1], 2, 2, QK_ROPE_DIM // 4)
    x1, x2 = xs[..., 0, :], xs[..., 1, :]
    out = jnp.stack([x1 * cos - x2 * sin, x1 * sin + x2 * cos], axis=-2)
    return out.reshape(x.shape)


def mla_queries(h, wq_a, q_norm, wq_b):
    B, T, _ = h.shape
    q = (rms_norm(h @ wq_a, q_norm) @ wq_b).reshape(B, T, MLA_HEADS, QK_NOPE_DIM + QK_ROPE_DIM)
    return q[..., :QK_NOPE_DIM], q[..., QK_NOPE_DIM:]


def mla_compress_kv(h, wkv_a, kv_norm):
    kv = h @ wkv_a
    return rms_norm(kv[..., :KV_LORA_RANK], kv_norm), kv[..., KV_LORA_RANK:]


def mla_expand_kv(ckv, wkv_b):
    B, L, _ = ckv.shape
    kv = (ckv @ wkv_b).reshape(B, L, MLA_HEADS, QK_NOPE_DIM + V_HEAD_DIM)
    return kv[..., :QK_NOPE_DIM], kv[..., QK_NOPE_DIM:]


def mla_attend(q_nope, q_pe, k_nope, k_pe, v):
    B, T, H, _ = q_nope.shape
    nb = T // Q_BLOCK
    scale = (QK_NOPE_DIM + QK_ROPE_DIM) ** -0.5

    def blocks(t):
        return jnp.moveaxis(t.reshape(B, nb, Q_BLOCK, *t.shape[2:]), 1, 0)

    def one_block(qs):
        qn, qp = qs
        s = jnp.einsum('bqhd,bkhd->bhqk', qn, k_nope) + jnp.einsum('bqhr,bkr->bhqk', qp, k_pe)
        p = jax.nn.softmax(s.astype(jnp.float32) * scale, axis=-1).astype(v.dtype)
        return jnp.einsum('bhqk,bkhd->bqhd', p, v)

    o = lax.map(one_block, (blocks(q_nope), blocks(q_pe)))
    return jnp.moveaxis(o, 0, 1).reshape(B, T, H * V_HEAD_DIM)


def mla_context(h, wq_a, q_norm, wq_b, wkv_a, kv_norm, wkv_b, wo):
    q_nope, q_pe = mla_queries(h, wq_a, q_norm, wq_b)
    ckv, kpe = mla_compress_kv(h, wkv_a, kv_norm)
    k_nope, v = mla_expand_kv(ckv, wkv_b)
    return mla_attend(q_nope, q_pe, k_nope, kpe, v) @ wo, ckv, kpe


def mla_latent(h, ckv_ctx, kpe_ctx, cos, sin, wq_a, q_norm, wq_b, wkv_a, kv_norm, wkv_b, wo):
    q_nope, q_pe = mla_queries(h, wq_a, q_norm, wq_b)
    q_pe = rope_2d(q_pe, cos[:, None], sin[:, None])
    ckv, kpe = mla_compress_kv(h, wkv_a, kv_norm)
    kpe = rope_2d(kpe, cos, sin)
    k_nope, v = mla_expand_kv(jnp.concatenate([ckv_ctx, ckv], axis=1), wkv_b)
    k_pe = jnp.concatenate([kpe_ctx, kpe], axis=1)
    return mla_attend(q_nope, q_pe, k_nope, k_pe, v) @ wo


def split_heads(t):
    return t.reshape(*t.shape[:-1], RWKV_HEADS, RWKV_HEAD)


def token_shift_centred(x):
    prev = jnp.pad(x[:, :-1], ((0, 0), (1, 0), (0, 0)))
    nxt = jnp.pad(x[:, 1:], ((0, 0), (0, 1), (0, 0)))
    return 0.5 * (prev + nxt)


def wkv7_scan(r, w, k, v, a, b, s0, reverse):
    f32 = jnp.float32
    seq = tuple(jnp.moveaxis(t.astype(f32), 1, 0) for t in (r, w, k, v, a, b))

    def step(S, inp):
        rt, wt, kt, vt, at, bt = inp
        sa = jnp.einsum('bhvk,bhk->bhv', S, at)
        S = S * wt[:, :, None, :] + sa[..., None] * bt[:, :, None, :] + vt[..., None] * kt[:, :, None, :]
        return S, jnp.einsum('bhvk,bhk->bhv', S, rt)

    s_fin, y = lax.scan(step, s0.astype(f32), seq, reverse=reverse)
    return jnp.moveaxis(y, 0, 1), s_fin


def rwkv7_bidir(h, s0_f, s0_b, mu, wr, wk, wv, w0, w1, w2, a0, a1, a2, g1, g2,
                k_k, k_a, r_k, lnx_g, lnx_b, wo):
    B, T, D = h.shape
    xx = token_shift_centred(h) - h
    xr, xw, xk, xv, xa, xg = (h + xx * mu[i] for i in range(6))
    r = split_heads(xr @ wr)
    k = xk @ wk
    v = split_heads(xv @ wv)
    g = jax.nn.sigmoid(xg @ g1) @ g2
    kkf = split_heads(k * k_k).astype(jnp.float32)
    kk = kkf / jnp.maximum(jnp.sqrt(jnp.sum(kkf * kkf, -1, keepdims=True)), 1e-12)

    def direction(d, s0, reverse):
        logw = -jax.nn.softplus(-(w0[d] + jnp.tanh(xw @ w1[d]) @ w2[d]).astype(jnp.float32)) - 0.5
        decay = jnp.exp(-jnp.exp(logw))
        a = jax.nn.sigmoid(a0[d] + (xa @ a1[d]) @ a2[d])
        kd = k * (1.0 + (a - 1.0) * k_a)
        y, s = wkv7_scan(r, split_heads(decay), split_heads(kd), v, -kk, kk * split_heads(a), s0, reverse)
        return y, s, kd

    y_f, s_f, k_f = direction(0, s0_f, False)
    y_b, s_b, k_b = direction(1, s0_b, True)
    y = y_f + y_b
    mu_y = y.mean(-1, keepdims=True)
    var_y = jnp.square(y - mu_y).mean(-1, keepdims=True)
    yn = ((y - mu_y) * lax.rsqrt(var_y + RWKV_GN_EPS)).reshape(B, T, D) * lnx_g + lnx_b
    bonus = jnp.sum(r * split_heads(k_f + k_b) * r_k, -1, keepdims=True) * v
    out = (yn.astype(h.dtype) + bonus.reshape(B, T, D)) * g
    return out @ wo, s_f, s_b


def multiscale_pool(h, w_grp, scale):
    B, T, D = h.shape
    C = POOL_GROUP
    hf = h.astype(jnp.float32)
    cs = jnp.pad(lax.cumsum(hf, axis=1), ((0, 0), (1, 0), (0, 0)))
    t = jnp.arange(T)
    parts = []
    for gi, win in enumerate(POOL_WINDOWS):
        lo = jnp.clip(t - win // 2, 0, T)
        hi = jnp.clip(t - win // 2 + win, 0, T)
        sl = slice(gi * C, (gi + 1) * C)
        cnt = (hi - lo).astype(jnp.float32)[None, :, None]
        parts.append((cs[:, hi, sl] - cs[:, lo, sl]) / cnt - hf[:, :, sl])
    pooled = jnp.stack(parts, axis=2).astype(h.dtype)
    out = jnp.einsum('btgc,gcd->btgd', pooled, w_grp).reshape(B, T, D)
    return out * scale


def setup_inputs(seed: int = 0):
    key = jax.random.key(seed)
    keys = iter(jax.random.split(key, 64))
    f32 = jnp.float32
    D, H, N = D_MODEL, RWKV_HEADS, RWKV_HEAD
    NA, NB, NC = N_ATTN_LAYERS, N_RWKV_LAYERS, N_POOL_LAYERS
    G, C = len(POOL_WINDOWS), POOL_GROUP
    qk_dim = QK_NOPE_DIM + QK_ROPE_DIM

    def nrm(shape, scale):
        return scale * jax.random.normal(next(keys), shape, f32)

    def uni(shape, lo, hi):
        return jax.random.uniform(next(keys), shape, f32, lo, hi)

    return {
        'x_prompt': nrm((BATCH, SEQ, D), 1.0),
        'x_sample': nrm((DEC_BATCH, DEC_SEQ, D), 1.0),
        'cache_ckv': nrm((DEC_BATCH, NA, PAST_LEN, KV_LORA_RANK), 1.0),
        'cache_kpe': nrm((DEC_BATCH, NA, PAST_LEN, QK_ROPE_DIM), 1.0),
        'state_wkv': nrm((DEC_BATCH, NB, 2, H, N, N), 0.5),
        'c': nrm((DEC_BATCH, D), 1.0),
        'c_ctx': nrm((D,), 1.0),
        'ada_w': nrm((DEPTH, D, 6 * D), D ** -0.5),
        'ada_b': nrm((DEPTH, 6 * D), 0.02),
        'ln_g': 1.0 + nrm((DEPTH, 2, D), 0.1),
        'ln_b': nrm((DEPTH, 2, D), 0.02),
        'ffn_wg': nrm((DEPTH, D, D_FF), D ** -0.5),
        'ffn_wu': nrm((DEPTH, D, D_FF), D ** -0.5),
        'ffn_wd': nrm((DEPTH, D_FF, D), BETA * D_FF ** -0.5),
        'mla_wq_a': nrm((NA, D, Q_LORA_RANK), D ** -0.5),
        'mla_q_norm': 1.0 + nrm((NA, Q_LORA_RANK), 0.1),
        'mla_wq_b': nrm((NA, Q_LORA_RANK, MLA_HEADS * qk_dim), Q_LORA_RANK ** -0.5),
        'mla_wkv_a': nrm((NA, D, KV_LORA_RANK + QK_ROPE_DIM), D ** -0.5),
        'mla_kv_norm': 1.0 + nrm((NA, KV_LORA_RANK), 0.1),
        'mla_wkv_b': nrm((NA, KV_LORA_RANK, MLA_HEADS * (QK_NOPE_DIM + V_HEAD_DIM)), KV_LORA_RANK ** -0.5),
        'mla_wo': nrm((NA, MLA_HEADS * V_HEAD_DIM, D), BETA * (MLA_HEADS * V_HEAD_DIM) ** -0.5),
        'rwkv_mu': uni((NB, 6, D), 0.0, 1.0),
        'rwkv_wr': nrm((NB, D, D), D ** -0.5),
        'rwkv_wk': nrm((NB, D, D), D ** -0.5),
        'rwkv_wv': nrm((NB, D, D), D ** -0.5),
        'rwkv_w0': uni((NB, 2, D), -6.0, 0.0),
        'rwkv_w1': nrm((NB, 2, D, DECAY_LORA), D ** -0.5),
        'rwkv_w2': nrm((NB, 2, DECAY_LORA, D), 0.5 * DECAY_LORA ** -0.5),
        'rwkv_a0': nrm((NB, 2, D), 0.1),
        'rwkv_a1': nrm((NB, 2, D, AAA_LORA), D ** -0.5),
        'rwkv_a2': nrm((NB, 2, AAA_LORA, D), AAA_LORA ** -0.5),
        'rwkv_g1': nrm((NB, D, GATE_LORA), D ** -0.5),
        'rwkv_g2': nrm((NB, GATE_LORA, D), GATE_LORA ** -0.5),
        'rwkv_k_k': 0.85 + nrm((NB, D), 0.05),
        'rwkv_k_a': 1.0 + nrm((NB, D), 0.05),
        'rwkv_r_k': nrm((NB, H, N), 0.1),
        'rwkv_lnx_g': 1.0 + nrm((NB, D), 0.1),
        'rwkv_lnx_b': nrm((NB, D), 0.02),
        'rwkv_wo': nrm((NB, D, D), BETA * D ** -0.5),
        'pool_w': nrm((NC, G, C, C), BETA * C ** -0.5),
        'pool_scale': 1.0 + nrm((NC, D), 0.1),
    }


def reference(x_prompt, x_sample, cache_ckv, cache_kpe, state_wkv, c, c_ctx,
              ada_w, ada_b, ln_g, ln_b, ffn_wg, ffn_wu, ffn_wd,
              mla_wq_a, mla_q_norm, mla_wq_b, mla_wkv_a, mla_kv_norm, mla_wkv_b, mla_wo,
              rwkv_mu, rwkv_wr, rwkv_wk, rwkv_wv, rwkv_w0, rwkv_w1, rwkv_w2,
              rwkv_a0, rwkv_a1, rwkv_a2, rwkv_g1, rwkv_g2, rwkv_k_k, rwkv_k_a, rwkv_r_k,
              rwkv_lnx_g, rwkv_lnx_b, rwkv_wo, pool_w, pool_scale):
    cos, sin = axial_rope(x_sample.shape[1], x_sample.dtype)
    yp, ys = x_prompt, x_sample
    new_ckv, new_kpe, new_wkv = [], [], []
    for layer in range(DEPTH):
        kind, j = layer % N_MIXERS, layer // N_MIXERS
        mp = adaln(c_ctx, ada_w[layer], ada_b[layer])
        ms = adaln(c, ada_w[layer], ada_b[layer])
        hp = modulate(yp, mp[0], mp[1])
        hs = modulate(ys, ms[0], ms[1])
        if kind == 0:
            wts = (mla_wq_a[j], mla_q_norm[j], mla_wq_b[j], mla_wkv_a[j], mla_kv_norm[j], mla_wkv_b[j], mla_wo[j])
            op, ckv, kpe = mla_context(hp, *wts)
            os_ = mla_latent(hs, cache_ckv[:, j], cache_kpe[:, j], cos, sin, *wts)
            new_ckv.append(ckv)
            new_kpe.append(kpe)
        elif kind == 1:
            wts = (rwkv_mu[j], rwkv_wr[j], rwkv_wk[j], rwkv_wv[j], rwkv_w0[j], rwkv_w1[j], rwkv_w2[j],
                   rwkv_a0[j], rwkv_a1[j], rwkv_a2[j], rwkv_g1[j], rwkv_g2[j], rwkv_k_k[j], rwkv_k_a[j],
                   rwkv_r_k[j], rwkv_lnx_g[j], rwkv_lnx_b[j], rwkv_wo[j])
            zeros = jnp.zeros((yp.shape[0], RWKV_HEADS, RWKV_HEAD, RWKV_HEAD), jnp.float32)
            op, s_f, s_b = rwkv7_bidir(hp, zeros, zeros, *wts)
            os_, _, _ = rwkv7_bidir(hs, state_wkv[:, j, 0], state_wkv[:, j, 1], *wts)
            new_wkv.append(jnp.stack([s_f, s_b], axis=1).astype(yp.dtype))
        else:
            op = multiscale_pool(hp, pool_w[j], pool_scale[j])
            os_ = multiscale_pool(hs, pool_w[j], pool_scale[j])
        yp = layer_norm(ALPHA * yp + mp[2] * op, ln_g[layer, 0], ln_b[layer, 0])
        ys = layer_norm(ALPHA * ys + ms[2] * os_, ln_g[layer, 0], ln_b[layer, 0])
        fp = swiglu(modulate(yp, mp[3], mp[4]), ffn_wg[layer], ffn_wu[layer], ffn_wd[layer])
        fs = swiglu(modulate(ys, ms[3], ms[4]), ffn_wg[layer], ffn_wu[layer], ffn_wd[layer])
        yp = layer_norm(ALPHA * yp + mp[5] * fp, ln_g[layer, 1], ln_b[layer, 1])
        ys = layer_norm(ALPHA * ys + ms[5] * fs, ln_g[layer, 1], ln_b[layer, 1])
    return (yp, ys, jnp.stack(new_ckv, axis=1), jnp.stack(new_kpe, axis=1), jnp.stack(new_wkv, axis=1))
```

```cpp
#include <hip/hip_runtime.h>
#include <cstdio>
#include <cstdint>

#define GAS __attribute__((address_space(1)))
#define LAS __attribute__((address_space(3)))
typedef unsigned short bf16_t;
typedef float f32x4 __attribute__((ext_vector_type(4)));
typedef float f32x2 __attribute__((ext_vector_type(2)));
typedef unsigned u32x4 __attribute__((ext_vector_type(4)));
typedef unsigned u32x2 __attribute__((ext_vector_type(2)));
typedef short bf16x8 __attribute__((ext_vector_type(8)));

constexpr int DM = 1024, NPR = 8192, MROWS = 16384, DFF = 2816, NHEAD = 16;
constexpr int KVR = 17408;
constexpr float ALPHA = 1.681792830507429f;
constexpr int OUT_YP = 0, OUT_YS = 8388608, OUT_CKV = 16777216, OUT_KPE = 20971520, OUT_WKV = 21495808, OUT_TOTAL = 25690112;

constexpr size_t MiB = 1u << 20;
constexpr size_t WS_CTL = 0, CTL_ZERO_BYTES = 1 * MiB;
constexpr size_t WS_MOD = 1 * MiB;
constexpr size_t WS_ROPE = WS_MOD + 512 * 1024;
constexpr size_t WS_BON = WS_MOD + 576 * 1024;
constexpr size_t WS_W = 2 * MiB;
constexpr size_t W_FFN_GU = 0, W_FFN_D = 11 * MiB, W_FFN_STRIDE = 16 * MiB + 512 * 1024;
constexpr size_t W_MLA = 66 * MiB, W_MLA_STRIDE = 6 * MiB;
constexpr size_t W_MLA_1 = 0, W_MLA_QB = 1536 * 1024, W_MLA_KVB = 1536 * 1024 + 1152 * 1024, W_MLA_O = 1536 * 1024 + 1152 * 1024 + 1024 * 1024;
constexpr size_t W_RW = 78 * MiB;
constexpr size_t W_RW_1 = 0, W_RW_G2T = 7 * MiB + 512 * 1024, W_RW_O = 8 * MiB, W_RW_W2T = 10 * MiB, W_RW_A2T = 10 * MiB + 256 * 1024;
constexpr size_t W_POOL = 91 * MiB;
constexpr size_t WS_X = 94 * MiB;
constexpr size_t WS_H = 158 * MiB;
constexpr size_t WS_SCR = 190 * MiB;
constexpr size_t WS_END = 384 * MiB;
constexpr size_t S_R1 = 0, S_Q = 0, S_KV = 48 * MiB, S_O = 116 * MiB, S_QA = 148 * MiB, S_CKV = 160 * MiB, S_KPE = 169 * MiB;
constexpr size_t S_ACT = 0;
constexpr size_t S_POOL = 0;
constexpr size_t R_XA = 0, R_R = 96 * MiB, R_K = 128 * MiB, R_V = 160 * MiB, R_T2 = 192 * MiB, R_SG = 200 * MiB, R_Y = 0, R_QT = 64 * MiB, R_EP = 208 * MiB, R_BON = 224 * MiB, R_G = 96 * MiB, R_SS = 128 * MiB;

constexpr int NWAVES = 8;
constexpr int LDS_BYTES = 147456;
constexpr int MISC_OFF = LDS_BYTES - 128;
constexpr int CW_BAR = 4096;

__device__ __forceinline__ unsigned f2bf(float f) { unsigned u = __builtin_bit_cast(unsigned, f); return (u + 0x7fffu + ((u >> 16) & 1u)) >> 16; }
__device__ __forceinline__ unsigned pk2(float lo, float hi) { return f2bf(lo) | (f2bf(hi) << 16); }
__device__ __forceinline__ float bf2f(unsigned short b) { return __builtin_bit_cast(float, (unsigned)b << 16); }
__device__ __forceinline__ float bflo(unsigned w) { return __builtin_bit_cast(float, w << 16); }
__device__ __forceinline__ float bfhi(unsigned w) { return __builtin_bit_cast(float, w & 0xffff0000u); }
__device__ __forceinline__ float wave_sum(float v) {
#pragma unroll
    for (int o = 1; o < 64; o <<= 1) v += __shfl_xor(v, o);
    return v;
}
__device__ __forceinline__ float wave_max(float v) {
#pragma unroll
    for (int o = 1; o < 64; o <<= 1) v = fmaxf(v, __shfl_xor(v, o));
    return v;
}
__device__ __forceinline__ float sigmoidf_(float x) { return 1.0f / (1.0f + __expf(-x)); }
__device__ __forceinline__ float siluf_(float x) { return x / (1.0f + __expf(-x)); }
__device__ __forceinline__ int cond_of_row(int row) { return row < NPR ? 0 : 1 + ((row - NPR) >> 12); }
__device__ __forceinline__ const float* modp(const float* MOD, int layer, int cond, int j) { return MOD + (size_t)((layer * 3 + cond) * 6 + j) * DM; }
__device__ __forceinline__ int perm32(int rho) { const int n = rho >> 4, i = rho & 15; return 8 * (i >> 2) + 4 * n + (i & 3); }

#define XB_TMO      128
#define XB_XCNT(j)  (256  + 64 * (j))
#define XB_XSUB(j)  (1280 + 64 * (j))
#define XB_XGEN(j)  (2304 + 64 * (j))
#define XB_TOP      3328
#define XB_TOPGEN   3392
#define XCD_BAR_WORDS 3456
#define XB_SPIN_CAP (1u << 18)
__device__ __forceinline__ unsigned xb_ld(unsigned* p)              { return __hip_atomic_load(p, __ATOMIC_RELAXED, __HIP_MEMORY_SCOPE_AGENT); }
__device__ __forceinline__ unsigned xb_add(unsigned* p, unsigned v) { return __hip_atomic_fetch_add(p, v, __ATOMIC_RELAXED, __HIP_MEMORY_SCOPE_AGENT); }
__device__ __forceinline__ unsigned xb_xcc_id() { return (unsigned)__builtin_amdgcn_s_getreg((3 << 11) | 20) & 0xFu; }
#define XB_SPIN(cond, bar) do { unsigned _sp = 0; while (cond) { __builtin_amdgcn_s_sleep(1); \
    if ((++_sp & 255u) == 0u) { if (xb_ld(&(bar)[XB_TMO])) break; if (_sp > XB_SPIN_CAP) { atomicAdd(&(bar)[XB_TMO], 1u); break; } } } } while (0)
struct XcdBarrier { unsigned* bar; unsigned x; volatile LAS unsigned* st; };
__device__ __forceinline__ XcdBarrier xcd_barrier_post(unsigned* bar, volatile LAS unsigned* st) {
    XcdBarrier b; b.bar = bar; b.x = xb_xcc_id(); b.st = st;
    if (threadIdx.x == 0) (void)xb_add(&bar[XB_XCNT(b.x)], 1u);
    return b;
}
__device__ __forceinline__ void xcd_barrier_complete(unsigned* bar, unsigned x, unsigned& nloc, unsigned& nx) {
    const unsigned G = gridDim.x * gridDim.y * gridDim.z;
    unsigned sum, cnt, mine, sp = 0u;
    for (;;) {
        sum = 0u; cnt = 0u; mine = 0u;
#pragma unroll
        for (unsigned j = 0; j < 16; ++j) { const unsigned c = xb_ld(&bar[XB_XCNT(j)]); sum += c; cnt += (c > 0u) ? 1u : 0u; mine = (j == x) ? c : mine; }
        if (sum == G) break;
        __builtin_amdgcn_s_sleep(1);
        if ((++sp & 255u) == 0u) { if (xb_ld(&bar[XB_TMO])) break; if (sp > XB_SPIN_CAP) { atomicAdd(&bar[XB_TMO], 1u); break; } }
    }
    nloc = mine > 0u ? mine : 1u; nx = cnt > 0u ? cnt : 1u;
}
__device__ __forceinline__ void xcd_barrier(const XcdBarrier& b) {
    asm volatile("s_waitcnt vmcnt(0)" ::: "memory");
    __syncthreads();
    if (threadIdx.x == 0) {
        unsigned* bar = b.bar;
        __builtin_amdgcn_s_waitcnt(0);
        unsigned nloc = b.st[0], nx = b.st[1];
        if (nloc == 0u) { xcd_barrier_complete(bar, b.x, nloc, nx); b.st[0] = nloc; b.st[1] = nx; }
        const unsigned old = xb_add(&bar[XB_XSUB(b.x)], 1u);
        const unsigned gen = old / nloc;
        if (old + 1u == (gen + 1u) * nloc) {
            __builtin_amdgcn_fence(__ATOMIC_RELEASE, "agent");
            asm volatile("s_waitcnt vmcnt(0)" ::: "memory");
            const unsigned og = xb_add(&bar[XB_TOP], 1u);
            const unsigned tg = og / nx;
            if (og + 1u == (tg + 1u) * nx) xb_add(&bar[XB_TOPGEN], 1u);
            else XB_SPIN(xb_ld(&bar[XB_TOPGEN]) == tg, bar);
            __builtin_amdgcn_fence(__ATOMIC_ACQUIRE, "agent");
            xb_add(&bar[XB_XGEN(b.x)], 1u);
            asm volatile("s_waitcnt vmcnt(0)" ::: "memory");
        } else {
            XB_SPIN(xb_ld(&bar[XB_XGEN(b.x)]) == gen, bar);
            __builtin_amdgcn_fence(__ATOMIC_ACQUIRE, "agent");
            asm volatile("s_waitcnt vmcnt(0)" ::: "memory");
        }
    }
    __syncthreads();
}
struct Args { const float* in[41]; float* out; unsigned char* ws; int ph_lo, ph_hi; };
enum { I_XP = 0, I_XS, I_CCKV, I_CKPE, I_SWKV, I_C, I_CCTX, I_ADAW, I_ADAB, I_LNG, I_LNB, I_WG, I_WU, I_WD, I_WQA, I_QNORM, I_WQB, I_WKVA, I_KVNORM, I_WKVB, I_MWO,
       I_MU, I_WR, I_WK, I_WV, I_W0, I_W1, I_W2, I_A0, I_A1, I_A2, I_G1, I_G2, I_KK, I_KA, I_RK, I_LNXG, I_LNXB, I_RWO, I_POOLW, I_POOLS };

struct Ctx {
    const Args* a;
    LAS unsigned char* lds;
    int tid, lane, wave, gw, NGW;
};

enum { MAP_ID = 0, MAP_GU = 1, MAP_QB = 2, MAP_KVA = 3 };
__device__ __forceinline__ int map_row(int map, int mp, int n) {
    if (map == MAP_ID) return mp + n;
    if (map == MAP_GU) return (n >> 2) * 8 + mp * 4 + (n & 3);
    if (map == MAP_QB) { const int h = n / 96, d = n - h * 96; if (d < 64) return n; const int i = d - 64; return h * 96 + 64 + (i & 16) + ((i & 7) << 1) + ((i >> 3) & 1); }
           { if (n < 256) return 384 + n; const int i = n - 256; return 640 + (i & 16) + ((i & 7) << 1) + ((i >> 3) & 1); }
}
__device__ __forceinline__ void conv_tile(const float* W, int ldw, int nblk, int tile, bf16_t* WT, int ldk, int koff, int map, int mp, LAS float* scr, int lane) {
    const int kb = tile / nblk, nb = tile - kb * nblk, k0 = 64 * kb, n0 = 32 * nb;
#pragma unroll 8
    for (int i = 0; i < 32; ++i) { const int kk = 2 * i + (lane >> 5); scr[kk * 33 + (lane & 31)] = W[(size_t)(k0 + kk) * ldw + n0 + (lane & 31)]; }
    asm volatile("s_waitcnt lgkmcnt(0)" ::: "memory");
    const int c = lane & 7;
#pragma unroll
    for (int j = 0; j < 4; ++j) { const int n = (lane >> 3) + 8 * j; const LAS float* s = scr + (8 * c) * 33 + n;
        u32x4 o; o.x = pk2(s[0 * 33], s[1 * 33]); o.y = pk2(s[2 * 33], s[3 * 33]); o.z = pk2(s[4 * 33], s[5 * 33]); o.w = pk2(s[6 * 33], s[7 * 33]);
        *(u32x4*)(WT + (size_t)map_row(map, mp, n0 + n) * ldk + koff + k0 + 8 * c) = o; }
    asm volatile("s_waitcnt lgkmcnt(0)" ::: "memory");
}
__device__ __forceinline__ void zero_rect_item(bf16_t* Wt, int ld, int r0, int c0, int nc, int item, int lane) {
    const int cpr = nc >> 3; const int idx = item * 64 + lane; const int r = idx / cpr, c = idx - r * cpr;
    *(u32x4*)(Wt + (size_t)(r0 + r) * ld + c0 + 8 * c) = (u32x4){0u, 0u, 0u, 0u};
}
__device__ __forceinline__ void adaln_item(const Ctx& C, int item, float* MOD) {
    const int layer = item / 96, cg = item - layer * 96, col = cg * 64 + C.lane;
    const float* W = C.a->in[I_ADAW] + (size_t)layer * DM * 6144 + col;
    const float* cx = C.a->in[I_CCTX]; const float* c0 = C.a->in[I_C]; const float* c1 = c0 + DM;
    float a0 = 0.f, a1 = 0.f, a2 = 0.f;
    for (int kb = 0; kb < DM; kb += 64) {
        const float s0 = siluf_(cx[kb + C.lane]), s1 = siluf_(c0[kb + C.lane]), s2 = siluf_(c1[kb + C.lane]);
#pragma unroll
        for (int kk = 0; kk < 64; ++kk) {
            const float w = W[(size_t)(kb + kk) * 6144];
            a0 = fmaf(__builtin_bit_cast(float, __builtin_amdgcn_readlane(__builtin_bit_cast(int, s0), kk)), w, a0);
            a1 = fmaf(__builtin_bit_cast(float, __builtin_amdgcn_readlane(__builtin_bit_cast(int, s1), kk)), w, a1);
            a2 = fmaf(__builtin_bit_cast(float, __builtin_amdgcn_readlane(__builtin_bit_cast(int, s2), kk)), w, a2);
        }
    }
    const float b = C.a->in[I_ADAB][layer * 6144 + col];
    MOD[(size_t)(layer * 3 + 0) * 6144 + col] = a0 + b;
    MOD[(size_t)(layer * 3 + 1) * 6144 + col] = a1 + b;
    MOD[(size_t)(layer * 3 + 2) * 6144 + col] = a2 + b;
}
__device__ __forceinline__ void rope_tables(float* ROPE, int t) {
    if (t >= 8) return;
    const double invf[8] = {1.0, 0.31622776601683794, 0.1, 0.031622776601683794, 0.01, 0.0031622776601683794, 0.001, 0.00031622776601683794};
    double th = 1.0;
#pragma unroll
    for (int f = 0; f < 8; ++f) th = (t == f) ? invf[f] : th;
    double s = 0.0, c = 0.0, term = 1.0;
#pragma unroll
    for (int n = 0; n < 22; ++n) { if ((n & 1) == 0) c += ((n & 2) ? -term : term); else s += ((n & 2) ? -term : term); term = term * th / (double)(n + 1); }
    double cr = 1.0, sr = 0.0;
    for (int p = 0; p < 64; ++p) { ROPE[p * 8 + t] = (float)cr; ROPE[512 + p * 8 + t] = (float)sr; const double c2 = cr * c - sr * s, s2 = sr * c + cr * s; cr = c2; sr = s2; }
}

#define JOB(n, call) { const int _n = (n); if (r < _n) { call; continue; } r -= _n; }
__device__ __forceinline__ void phase0(const Ctx& C) {
    unsigned char* ws = C.a->ws; bf16_t* WB = (bf16_t*)(ws + WS_W);
    LAS float* scr = (LAS float*)(C.lds + C.wave * 16384);
    float* MOD = (float*)(ws + WS_MOD);
    if (C.gw == 0) rope_tables((float*)(ws + WS_ROPE), C.lane);
    const float* const* in = C.a->in;
    constexpr int T_GU = (1024 / 64) * (2816 / 32), T_D = (2816 / 64) * (1024 / 32);
    constexpr int T_QA = 16 * 12, T_KVA = 16 * 9, T_QB = 6 * 48, T_KVB = 4 * 64, T_SQ = 16 * 32, T_W1 = 16 * 2, T_G1 = 16 * 4, T_G2 = 2 * 32, T_PW = 4 * 8, T_W2 = 1 * 32;
    constexpr int N_ADA = 4 * 96;
    constexpr int TOTAL = N_ADA + 4 * (2 * T_GU + T_D) + 2 * (T_QA + T_KVA + T_QB + T_KVB + T_SQ) + 3 * T_SQ + 4 * T_W1 + T_G1 + T_G2 + T_SQ + 4 * T_PW + 4 * T_W2
                        + 2 * (96 * 1024 / 8 / 64) + 3 * (128 * 1024 / 8 / 64) + (1024 * 128 / 8 / 64);
    for (int it = C.gw; it < TOTAL; it += C.NGW) {
        int r = it;
        JOB(N_ADA, adaln_item(C, r, MOD));
        bool done = false;
#pragma unroll 1
        for (int L = 0; L < 4 && !done; ++L) {
            bf16_t* gu = (bf16_t*)((unsigned char*)WB + L * W_FFN_STRIDE + W_FFN_GU); bf16_t* wd = (bf16_t*)((unsigned char*)WB + L * W_FFN_STRIDE + W_FFN_D);
            if (r < T_GU) { conv_tile(in[I_WG] + (size_t)L * 1024 * 2816, 2816, 88, r, gu, 1024, 0, MAP_GU, 0, scr, C.lane); done = true; break; } r -= T_GU;
            if (r < T_GU) { conv_tile(in[I_WU] + (size_t)L * 1024 * 2816, 2816, 88, r, gu, 1024, 0, MAP_GU, 1, scr, C.lane); done = true; break; } r -= T_GU;
            if (r < T_D)  { conv_tile(in[I_WD] + (size_t)L * 2816 * 1024, 1024, 32, r, wd, 2816, 0, MAP_ID, 0, scr, C.lane); done = true; break; } r -= T_D;
        }
        if (done) continue;
#pragma unroll 1
        for (int j = 0; j < 2 && !done; ++j) {
            unsigned char* wm = (unsigned char*)WB + W_MLA + j * W_MLA_STRIDE;
            if (r < T_QA)  { conv_tile(in[I_WQA] + (size_t)j * 1024 * 384, 384, 12, r, (bf16_t*)(wm + W_MLA_1), 1024, 0, MAP_ID, 0, scr, C.lane); done = true; break; } r -= T_QA;
            if (r < T_KVA) { conv_tile(in[I_WKVA] + (size_t)j * 1024 * 288, 288, 9, r, (bf16_t*)(wm + W_MLA_1), 1024, 0, MAP_KVA, 0, scr, C.lane); done = true; break; } r -= T_KVA;
            if (r < T_QB)  { conv_tile(in[I_WQB] + (size_t)j * 384 * 1536, 1536, 48, r, (bf16_t*)(wm + W_MLA_QB), 384, 0, MAP_QB, 0, scr, C.lane); done = true; break; } r -= T_QB;
            if (r < T_KVB) { conv_tile(in[I_WKVB] + (size_t)j * 256 * 2048, 2048, 64, r, (bf16_t*)(wm + W_MLA_KVB), 256, 0, MAP_ID, 0, scr, C.lane); done = true; break; } r -= T_KVB;
            if (r < T_SQ)  { conv_tile(in[I_MWO] + (size_t)j * 1024 * 1024, 1024, 32, r, (bf16_t*)(wm + W_MLA_O), 1024, 0, MAP_ID, 0, scr, C.lane); done = true; break; } r -= T_SQ;
        }
        if (done) continue;
        unsigned char* wr = (unsigned char*)WB + W_RW;
        bf16_t* w1c = (bf16_t*)(wr + W_RW_1);
        JOB(T_SQ, conv_tile(in[I_WR], 1024, 32, r, w1c, 1024, 0, MAP_ID, 0, scr, C.lane));
        JOB(T_SQ, conv_tile(in[I_WK], 1024, 32, r, w1c, 1024, 0, MAP_ID, 1024, scr, C.lane));
        JOB(T_SQ, conv_tile(in[I_WV], 1024, 32, r, w1c, 1024, 0, MAP_ID, 2048, scr, C.lane));
        JOB(T_W1, conv_tile(in[I_W1], 64, 2, r, w1c, 1024, 0, MAP_ID, 3072, scr, C.lane));
        JOB(T_W1, conv_tile(in[I_W1] + 1024 * 64, 64, 2, r, w1c, 1024, 0, MAP_ID, 3072 + 64, scr, C.lane));
        JOB(T_W1, conv_tile(in[I_A1], 64, 2, r, w1c, 1024, 0, MAP_ID, 3328, scr, C.lane));
        JOB(T_W1, conv_tile(in[I_A1] + 1024 * 64, 64, 2, r, w1c, 1024, 0, MAP_ID, 3328 + 64, scr, C.lane));
        JOB(T_G1, conv_tile(in[I_G1], 128, 4, r, w1c, 1024, 0, MAP_ID, 3584, scr, C.lane));
        JOB(T_G2, conv_tile(in[I_G2], 1024, 32, r, (bf16_t*)(wr + W_RW_G2T), 256, 0, MAP_ID, 0, scr, C.lane));
        JOB(T_SQ, conv_tile(in[I_RWO], 1024, 32, r, (bf16_t*)(wr + W_RW_O), 1024, 0, MAP_ID, 0, scr, C.lane));
        JOB(T_PW, conv_tile(in[I_POOLW] + 0 * 65536, 256, 8, r, (bf16_t*)((unsigned char*)WB + W_POOL), 256, 0, MAP_ID, 0, scr, C.lane));
        JOB(T_PW, conv_tile(in[I_POOLW] + 1 * 65536, 256, 8, r, (bf16_t*)((unsigned char*)WB + W_POOL), 256, 0, MAP_ID, 256, scr, C.lane));
        JOB(T_PW, conv_tile(in[I_POOLW] + 2 * 65536, 256, 8, r, (bf16_t*)((unsigned char*)WB + W_POOL), 256, 0, MAP_ID, 512, scr, C.lane));
        JOB(T_PW, conv_tile(in[I_POOLW] + 3 * 65536, 256, 8, r, (bf16_t*)((unsigned char*)WB + W_POOL), 256, 0, MAP_ID, 768, scr, C.lane));
        JOB(T_W2, conv_tile(in[I_W2], 1024, 32, r, (bf16_t*)(wr + W_RW_W2T), 64, 0, MAP_ID, 0, scr, C.lane));
        JOB(T_W2, conv_tile(in[I_W2] + 64 * 1024, 1024, 32, r, (bf16_t*)(wr + W_RW_W2T), 64, 0, MAP_ID, 1024, scr, C.lane));
        JOB(T_W2, conv_tile(in[I_A2], 1024, 32, r, (bf16_t*)(wr + W_RW_A2T), 64, 0, MAP_ID, 0, scr, C.lane));
        JOB(T_W2, conv_tile(in[I_A2] + 64 * 1024, 1024, 32, r, (bf16_t*)(wr + W_RW_A2T), 64, 0, MAP_ID, 1024, scr, C.lane));
        JOB(96 * 1024 / 8 / 64, zero_rect_item((bf16_t*)((unsigned char*)WB + W_MLA + W_MLA_1), 1024, 672, 0, 1024, r, C.lane));
        JOB(96 * 1024 / 8 / 64, zero_rect_item((bf16_t*)((unsigned char*)WB + W_MLA + W_MLA_STRIDE + W_MLA_1), 1024, 672, 0, 1024, r, C.lane));
        JOB(128 * 1024 / 8 / 64, zero_rect_item(w1c, 1024, 3200, 0, 1024, r, C.lane));
        JOB(128 * 1024 / 8 / 64, zero_rect_item(w1c, 1024, 3456, 0, 1024, r, C.lane));
        JOB(128 * 1024 / 8 / 64, zero_rect_item(w1c, 1024, 3712, 0, 1024, r, C.lane));
        JOB(1024 * 128 / 8 / 64, zero_rect_item((bf16_t*)(wr + W_RW_G2T), 256, 0, 128, 128, r, C.lane));
    }
}

__device__ __forceinline__ void store_h_row(bf16_t* Hrow, const f32x4 (&x)[4], const float* sh, const float* sc, int lane) {
#pragma unroll
    for (int j = 0; j < 4; ++j) { const int c = 4 * lane + 256 * j; const f32x4 s = *(const f32x4*)(sc + c), t = *(const f32x4*)(sh + c);
        u32x2 o; o.x = pk2(x[j].x * (1.f + s.x) + t.x, x[j].y * (1.f + s.y) + t.y); o.y = pk2(x[j].z * (1.f + s.z) + t.z, x[j].w * (1.f + s.w) + t.w);
        *(u32x2*)(Hrow + c) = o; }
}
__device__ __forceinline__ void phase_init(const Ctx& C) {
    unsigned char* ws = C.a->ws; float* X = (float*)(ws + WS_X); bf16_t* H = (bf16_t*)(ws + WS_H); const float* MOD = (const float*)(ws + WS_MOD);
    for (int row = C.gw; row < MROWS; row += C.NGW) {
        const float* src = row < NPR ? C.a->in[I_XP] + (size_t)row * DM : C.a->in[I_XS] + (size_t)(row - NPR) * DM;
        f32x4 x[4];
#pragma unroll
        for (int j = 0; j < 4; ++j) { x[j] = *(const f32x4*)(src + 4 * C.lane + 256 * j); *(f32x4*)(X + (size_t)row * DM + 4 * C.lane + 256 * j) = x[j]; }
        const int cd = cond_of_row(row);
        store_h_row(H + (size_t)row * DM, x, modp(MOD, 0, cd, 0), modp(MOD, 0, cd, 1), C.lane);
    }
}
__device__ __forceinline__ void phase_ln(const Ctx& C, int layer, int which, int hl, int hs, bool to_out) {
    unsigned char* ws = C.a->ws; float* X = (float*)(ws + WS_X); bf16_t* H = (bf16_t*)(ws + WS_H); const float* MOD = (const float*)(ws + WS_MOD);
    const float* g = C.a->in[I_LNG] + (size_t)(layer * 2 + which) * DM; const float* b = C.a->in[I_LNB] + (size_t)(layer * 2 + which) * DM;
    for (int row = C.gw; row < MROWS; row += C.NGW) {
        float* xr = X + (size_t)row * DM; f32x4 x[4]; float s = 0.f;
#pragma unroll
        for (int j = 0; j < 4; ++j) { x[j] = *(const f32x4*)(xr + 4 * C.lane + 256 * j); s += (x[j].x + x[j].y) + (x[j].z + x[j].w); }
        const float mean = wave_sum(s) * (1.f / DM); float q = 0.f;
#pragma unroll
        for (int j = 0; j < 4; ++j) { x[j] = x[j] - mean; q += (x[j].x * x[j].x + x[j].y * x[j].y) + (x[j].z * x[j].z + x[j].w * x[j].w); }
        const float rstd = 1.0f / sqrtf(wave_sum(q) * (1.f / DM) + 1e-5f);
#pragma unroll
        for (int j = 0; j < 4; ++j) { const int c = 4 * C.lane + 256 * j; const f32x4 gg = *(const f32x4*)(g + c), bb = *(const f32x4*)(b + c);
            x[j] = x[j] * rstd * gg + bb; *(f32x4*)(xr + c) = x[j];
            if (to_out) *(f32x4*)(C.a->out + (size_t)row * DM + c) = x[j]; }
        if (hs >= 0) { const int cd = cond_of_row(row); store_h_row(H + (size_t)row * DM, x, modp(MOD, hl, cd, hs), modp(MOD, hl, cd, hs + 1), C.lane); }
    }
}

template <class ASel, class Epi>
__device__ __forceinline__ void gemm_simple(const Ctx& C, const ASel& asel, int lda, const bf16_t* Bt, int ldb, int Mr, int N, int K, const Epi& epi) {
    const int nTm = Mr >> 6, nTn = N >> 6, fr = C.lane & 15, fq = C.lane >> 4;
    for (int t = C.gw; t < nTm * nTn; t += C.NGW) {
        const int tm = t / nTn, tn = t - tm * nTn, m0 = tm * 64, n0 = tn * 64;
        const bf16_t* A = asel(n0);
        f32x4 acc[4][2][2];
#pragma unroll
        for (int mi = 0; mi < 4; ++mi)
#pragma unroll
            for (int g = 0; g < 2; ++g) { acc[mi][g][0] = (f32x4){0.f, 0.f, 0.f, 0.f}; acc[mi][g][1] = (f32x4){0.f, 0.f, 0.f, 0.f}; }
        const bf16_t* ap = A + (size_t)(m0 + fr) * lda + 8 * fq;
        const bf16_t* bp0 = Bt + (size_t)(n0 + perm32(fr)) * ldb + 8 * fq;
        const bf16_t* bp1 = Bt + (size_t)(n0 + perm32(16 + fr)) * ldb + 8 * fq;
        for (int k0 = 0; k0 < K; k0 += 32) {
            bf16x8 af[4], bf[2][2];
#pragma unroll
            for (int mi = 0; mi < 4; ++mi) af[mi] = *(const bf16x8*)(ap + (size_t)(16 * mi) * lda + k0);
#pragma unroll
            for (int g = 0; g < 2; ++g) { bf[g][0] = *(const bf16x8*)(bp0 + (size_t)(32 * g) * ldb + k0); bf[g][1] = *(const bf16x8*)(bp1 + (size_t)(32 * g) * ldb + k0); }
#pragma unroll
            for (int mi = 0; mi < 4; ++mi)
#pragma unroll
                for (int g = 0; g < 2; ++g) {
                    acc[mi][g][0] = __builtin_amdgcn_mfma_f32_16x16x32_bf16(bf[g][0], af[mi], acc[mi][g][0], 0, 0, 0);
                    acc[mi][g][1] = __builtin_amdgcn_mfma_f32_16x16x32_bf16(bf[g][1], af[mi], acc[mi][g][1], 0, 0, 0);
                }
        }
#pragma unroll
        for (int mi = 0; mi < 4; ++mi)
#pragma unroll
            for (int g = 0; g < 2; ++g) epi(m0 + 16 * mi + fr, n0 + 32 * g + 8 * fq, acc[mi][g][0], acc[mi][g][1]);
    }
}
struct ASelPlain { const bf16_t* A; __device__ __forceinline__ const bf16_t* operator()(int) const { return A; } };
struct ASelShift { const bf16_t* A; int shift; size_t stride; __device__ __forceinline__ const bf16_t* operator()(int n0) const { return A + (size_t)(n0 >> shift) * stride; } };

struct EpiF32 { float* out; int ldc;
    __device__ __forceinline__ void operator()(int row, int c0, f32x4 v0, f32x4 v1) const { float* o = out + (size_t)row * ldc + c0; *(f32x4*)o = v0; *(f32x4*)(o + 4) = v1; } };
struct EpiBf16 { bf16_t* out; int ldc;
    __device__ __forceinline__ void operator()(int row, int c0, f32x4 v0, f32x4 v1) const {
        u32x4 w; w.x = pk2(v0.x, v0.y); w.y = pk2(v0.z, v0.w); w.z = pk2(v1.x, v1.y); w.w = pk2(v1.z, v1.w); *(u32x4*)(out + (size_t)row * ldc + c0) = w; } };
struct EpiSwiglu { bf16_t* act;
    __device__ __forceinline__ void operator()(int row, int c0, f32x4 v0, f32x4 v1) const {
        u32x2 w; w.x = pk2(siluf_(v0.x) * v1.x, siluf_(v0.y) * v1.y); w.y = pk2(siluf_(v0.z) * v1.z, siluf_(v0.w) * v1.w);
        *(u32x2*)(act + (size_t)row * DFF + (c0 >> 1)) = w; } };
struct EpiResid { float* X; const float* MOD; int layer, gslot; const float* cscale;
    __device__ __forceinline__ void operator()(int row, int c0, f32x4 v0, f32x4 v1) const {
        const float* gt = modp(MOD, layer, cond_of_row(row), gslot) + c0; float* x = X + (size_t)row * DM + c0;
        f32x4 g0 = *(const f32x4*)gt, g1 = *(const f32x4*)(gt + 4);
        if (cscale) { g0 = g0 * *(const f32x4*)(cscale + c0); g1 = g1 * *(const f32x4*)(cscale + c0 + 4); }
        const f32x4 x0 = *(const f32x4*)x, x1 = *(const f32x4*)(x + 4);
        *(f32x4*)x = x0 * ALPHA + g0 * v0; *(f32x4*)(x + 4) = x1 * ALPHA + g1 * v1; } };
struct EpiRwA { bf16_t* R;
    __device__ __forceinline__ void operator()(int row, int c0, f32x4 v0, f32x4 v1) const {
        u32x4 w; w.x = pk2(v0.x, v0.y); w.y = pk2(v0.z, v0.w); w.z = pk2(v1.x, v1.y); w.w = pk2(v1.z, v1.w);
        *(u32x4*)(R + (size_t)(c0 >> 10) * ((size_t)MROWS * DM) + (size_t)row * DM + (c0 & 1023)) = w; } };
struct EpiRwB { bf16_t* T2; bf16_t* SG;
    __device__ __forceinline__ void operator()(int row, int c0, f32x4 v0, f32x4 v1) const {
        const int tile = c0 >> 8, cc = c0 & 255;
        if (tile == 0) { if (cc >= 128) return;
            u32x4 w; w.x = pk2(tanhf(v0.x), tanhf(v0.y)); w.y = pk2(tanhf(v0.z), tanhf(v0.w)); w.z = pk2(tanhf(v1.x), tanhf(v1.y)); w.w = pk2(tanhf(v1.z), tanhf(v1.w));
            *(u32x4*)(T2 + (size_t)row * 256 + cc) = w; }
        else if (tile == 1) { if (cc >= 128) return;
            u32x4 w; w.x = pk2(v0.x, v0.y); w.y = pk2(v0.z, v0.w); w.z = pk2(v1.x, v1.y); w.w = pk2(v1.z, v1.w);
            *(u32x4*)(T2 + (size_t)row * 256 + 128 + cc) = w; }
        else { u32x4 w; w.x = pk2(sigmoidf_(v0.x), sigmoidf_(v0.y)); w.y = pk2(sigmoidf_(v0.z), sigmoidf_(v0.w)); w.z = pk2(sigmoidf_(v1.x), sigmoidf_(v1.y)); w.w = pk2(sigmoidf_(v1.z), sigmoidf_(v1.w));
            *(u32x4*)(SG + (size_t)row * 256 + cc) = w; } } };
__device__ __forceinline__ int kv_row_of(int row) { return row < NPR ? row : NPR + ((row - NPR) >> 12) * 4608 + 512 + ((row - NPR) & 4095); }
__device__ __forceinline__ void phase_mla_norm(const Ctx& C, int j) {
    unsigned char* ws = C.a->ws; const float* R1 = (const float*)(ws + WS_SCR + S_R1);
    bf16_t* QA = (bf16_t*)(ws + WS_SCR + S_QA); bf16_t* CKV = (bf16_t*)(ws + WS_SCR + S_CKV); bf16_t* KPE = (bf16_t*)(ws + WS_SCR + S_KPE);
    const float* ROPE = (const float*)(ws + WS_ROPE);
    const float* qn = C.a->in[I_QNORM] + j * 384; const float* kvn = C.a->in[I_KVNORM] + j * 256; float* out = C.a->out;
    const int lane = C.lane;
    for (int row = C.gw; row < MROWS + 1024; row += C.NGW) {
        if (row < MROWS) {
            const float* r = R1 + (size_t)row * 768;
            f32x2 q[3]; float s = 0.f;
#pragma unroll
            for (int jj = 0; jj < 3; ++jj) { q[jj] = *(const f32x2*)(r + 2 * lane + 128 * jj); s += q[jj].x * q[jj].x + q[jj].y * q[jj].y; }
            const float rstd = 1.0f / sqrtf(wave_sum(s) * (1.f / 384.f) + 1e-6f);
#pragma unroll
            for (int jj = 0; jj < 3; ++jj) { const int c = 2 * lane + 128 * jj; const f32x2 g = *(const f32x2*)(qn + c);
                *(unsigned*)(QA + (size_t)row * 384 + c) = pk2(q[jj].x * rstd * g.x, q[jj].y * rstd * g.y); }
            const f32x4 kv = *(const f32x4*)(r + 384 + 4 * lane);
            const float rstd2 = 1.0f / sqrtf(wave_sum((kv.x * kv.x + kv.y * kv.y) + (kv.z * kv.z + kv.w * kv.w)) * (1.f / 256.f) + 1e-6f);
            const f32x4 o = kv * rstd2 * *(const f32x4*)(kvn + 4 * lane);
            const int kvrow = kv_row_of(row);
            u32x2 w; w.x = pk2(o.x, o.y); w.y = pk2(o.z, o.w);
            *(u32x2*)(CKV + (size_t)kvrow * 256 + 4 * lane) = w;
            const int b = row >> 8, t = row & 255;
            if (row < NPR) *(f32x4*)(out + OUT_CKV + ((size_t)(b * 2 + j) * 256 + t) * 256 + 4 * lane) = o;
            if (lane < 16) {
                const int p = lane, ax = p >> 3, f = p & 7;
                float x1 = r[640 + 2 * p], x2 = r[640 + 2 * p + 1];
                if (row < NPR) { float* ok = out + OUT_KPE + ((size_t)(b * 2 + j) * 256 + t) * 32 + ax * 16 + f; ok[0] = x1; ok[8] = x2; }
                else { const int tt = (row - NPR) & 4095; const int pos = ax == 0 ? (tt >> 6) : (tt & 63);
                    const float c = ROPE[pos * 8 + f], sn = ROPE[512 + pos * 8 + f]; const float o1 = x1 * c - x2 * sn, o2 = x1 * sn + x2 * c; x1 = o1; x2 = o2; }
                *(unsigned*)(KPE + (size_t)kvrow * 32 + 2 * p) = pk2(x1, x2);
            }
        } else {
            const int idx = row - MROWS, b = idx >> 9, i = idx & 511; const int kvrow = NPR + b * 4608 + i;
            const float* sc = C.a->in[I_CCKV] + ((size_t)(b * 2 + j) * 512 + i) * 256;
            const f32x4 v = *(const f32x4*)(sc + 4 * lane);
            u32x2 w; w.x = pk2(v.x, v.y); w.y = pk2(v.z, v.w);
            *(u32x2*)(CKV + (size_t)kvrow * 256 + 4 * lane) = w;
            if (lane < 16) { const int p = lane, ax = p >> 3, f = p & 7; const float* sk = C.a->in[I_CKPE] + ((size_t)(b * 2 + j) * 512 + i) * 32 + ax * 16 + f;
                *(unsigned*)(KPE + (size_t)kvrow * 32 + 2 * p) = pk2(sk[0], sk[8]); }
        }
    }
}

#define RDL(v, i) __builtin_bit_cast(float, __builtin_amdgcn_readlane(__builtin_bit_cast(int, (v)), (i)))
__device__ __forceinline__ void phase_attn_simple(const Ctx& C) {
    unsigned char* ws = C.a->ws; const bf16_t* Q = (const bf16_t*)(ws + WS_SCR + S_Q); const bf16_t* KV = (const bf16_t*)(ws + WS_SCR + S_KV);
    const bf16_t* KPE = (const bf16_t*)(ws + WS_SCR + S_KPE); bf16_t* O = (bf16_t*)(ws + WS_SCR + S_O); const float* ROPE = (const float*)(ws + WS_ROPE);
    const int lane = C.lane; const float scale = 0.10206207261596577f;
    for (int it = C.gw; it < MROWS * 16; it += C.NGW) {
        const int row = it >> 4, h = it & 15;
        int kbase, ntile;
        if (row < NPR) { kbase = row & ~255; ntile = 4; } else { kbase = NPR + ((row - NPR) >> 12) * 4608; ntile = 72; }
        const bf16_t* qrow = Q + (size_t)row * 1536 + h * 96;
        float qa = bf2f(qrow[lane]); float qb = bf2f(qrow[64 + (lane & 31)]);
        if (row >= NPR) { const int tt = (row - NPR) & 4095; const int p = (lane & 31) >> 1, ax = p >> 3, f = p & 7; const int pos = ax == 0 ? (tt >> 6) : (tt & 63);
            const float c = ROPE[pos * 8 + f], sn = ROPE[512 + pos * 8 + f]; const float other = __shfl_xor(qb, 1);
            qb = (lane & 1) ? (other * sn + qb * c) : (qb * c - other * sn); }
        qa *= scale; qb *= scale;
        float m = -1e30f, l = 0.f, acc = 0.f;
        for (int tile = 0; tile < ntile; ++tile) {
            const int key = kbase + tile * 64 + lane;
            const u32x4* kn = (const u32x4*)(KV + (size_t)key * 2048 + h * 128); const u32x4* kp = (const u32x4*)(KPE + (size_t)key * 32);
            float s = 0.f;
#pragma unroll
            for (int c8 = 0; c8 < 8; ++c8) { const u32x4 w = kn[c8];
                s = fmaf(RDL(qa, 8 * c8 + 0), bflo(w.x), s); s = fmaf(RDL(qa, 8 * c8 + 1), bfhi(w.x), s); s = fmaf(RDL(qa, 8 * c8 + 2), bflo(w.y), s); s = fmaf(RDL(qa, 8 * c8 + 3), bfhi(w.y), s);
                s = fmaf(RDL(qa, 8 * c8 + 4), bflo(w.z), s); s = fmaf(RDL(qa, 8 * c8 + 5), bfhi(w.z), s); s = fmaf(RDL(qa, 8 * c8 + 6), bflo(w.w), s); s = fmaf(RDL(qa, 8 * c8 + 7), bfhi(w.w), s); }
#pragma unroll
            for (int c8 = 0; c8 < 4; ++c8) { const u32x4 w = kp[c8];
                s = fmaf(RDL(qb, 8 * c8 + 0), bflo(w.x), s); s = fmaf(RDL(qb, 8 * c8 + 1), bfhi(w.x), s); s = fmaf(RDL(qb, 8 * c8 + 2), bflo(w.y), s); s = fmaf(RDL(qb, 8 * c8 + 3), bfhi(w.y), s);
                s = fmaf(RDL(qb, 8 * c8 + 4), bflo(w.z), s); s = fmaf(RDL(qb, 8 * c8 + 5), bfhi(w.z), s); s = fmaf(RDL(qb, 8 * c8 + 6), bflo(w.w), s); s = fmaf(RDL(qb, 8 * c8 + 7), bfhi(w.w), s); }
            const float mn = fmaxf(m, wave_max(s)); const float alpha = __expf(m - mn); const float p = __expf(s - mn);
            l = l * alpha + wave_sum(p); acc *= alpha; m = mn;
            const bf16_t* vb = KV + (size_t)(kbase + tile * 64) * 2048 + h * 128 + 64 + lane;
#pragma unroll 16
            for (int jj = 0; jj < 64; ++jj) acc = fmaf(RDL(p, jj), bf2f(vb[(size_t)jj * 2048]), acc);
        }
        O[(size_t)row * 1024 + h * 64 + lane] = (bf16_t)f2bf(acc / l);
    }
}

__device__ __forceinline__ void phase_rw_prep(const Ctx& C, int layer, int part) {
    unsigned char* ws = C.a->ws; const float* X = (const float*)(ws + WS_X); bf16_t* XA = (bf16_t*)(ws + WS_H + R_XA); const float* MOD = (const float*)(ws + WS_MOD);
    const float* mu = C.a->in[I_MU]; const int lane = C.lane;
    const int i0 = part == 0 ? 0 : 1, i1 = part == 0 ? 2 : 4, i2 = part == 0 ? 3 : 5;
    for (int row = C.gw; row < MROWS; row += C.NGW) {
        int t, T; if (row < NPR) { t = row & 255; T = 256; } else { t = (row - NPR) & 4095; T = 4096; }
        const int cd = cond_of_row(row); const float* sh = modp(MOD, layer, cd, 0); const float* sc = modp(MOD, layer, cd, 1);
        const float* xr = X + (size_t)row * DM;
#pragma unroll
        for (int j = 0; j < 4; ++j) { const int c = 4 * lane + 256 * j;
            const f32x4 s1 = *(const f32x4*)(sc + c) + 1.0f, s0 = *(const f32x4*)(sh + c);
            const f32x4 h = *(const f32x4*)(xr + c) * s1 + s0;
            f32x4 hp = (f32x4){0.f, 0.f, 0.f, 0.f}, hn = (f32x4){0.f, 0.f, 0.f, 0.f};
            if (t > 0) hp = *(const f32x4*)(xr - DM + c) * s1 + s0;
            if (t < T - 1) hn = *(const f32x4*)(xr + DM + c) * s1 + s0;
            const f32x4 xx = (hp + hn) * 0.5f - h;
            const f32x4 o0 = h + xx * *(const f32x4*)(mu + i0 * DM + c), o1 = h + xx * *(const f32x4*)(mu + i1 * DM + c), o2 = h + xx * *(const f32x4*)(mu + i2 * DM + c);
            u32x2 w; w.x = pk2(o0.x, o0.y); w.y = pk2(o0.z, o0.w); *(u32x2*)(XA + (size_t)row * DM + c) = w;
            w.x = pk2(o1.x, o1.y); w.y = pk2(o1.z, o1.w); *(u32x2*)(XA + (size_t)MROWS * DM + (size_t)row * DM + c) = w;
            w.x = pk2(o2.x, o2.y); w.y = pk2(o2.z, o2.w); *(u32x2*)(XA + (size_t)2 * MROWS * DM + (size_t)row * DM + c) = w; }
    }
}

__device__ __forceinline__ float dpp_x1(float v) { return __builtin_bit_cast(float, __builtin_amdgcn_mov_dpp(__builtin_bit_cast(int, v), 0xB1, 0xF, 0xF, true)); }
__device__ __forceinline__ float dpp_x2(float v) { return __builtin_bit_cast(float, __builtin_amdgcn_mov_dpp(__builtin_bit_cast(int, v), 0x4E, 0xF, 0xF, true)); }

constexpr int SCAN_BLK = 8;
__device__ __forceinline__ void scan_item(const Ctx& C, int row_first, int T, int h, int dir, int init, const float* initp, bool hasv, bf16_t* yout, float* endp, float* bon) {
    unsigned char* ws = C.a->ws; const float* const* in = C.a->in;
    const bf16_t* Rb = (const bf16_t*)(ws + WS_H + R_R); const bf16_t* Kb = (const bf16_t*)(ws + WS_H + R_K); const bf16_t* Vb = (const bf16_t*)(ws + WS_H + R_V);
    const bf16_t* T2 = (const bf16_t*)(ws + WS_H + R_T2);
    LAS float* opb = (LAS float*)(C.lds + C.wave * 16384);
    const int lane = C.lane, ks = lane & 3, vg = lane >> 2, ch = h * 64 + lane;
    const float w0c = in[I_W0][dir * DM + ch], a0c = in[I_A0][dir * DM + ch], kkc = in[I_KK][ch], kac = in[I_KA][ch], rkc = in[I_RK][ch];
    const float* w2p = in[I_W2] + (size_t)dir * 64 * DM + ch; const float* a2p = in[I_A2] + (size_t)dir * 64 * DM + ch;
    float S[4][16];
#pragma unroll
    for (int i = 0; i < 4; ++i)
#pragma unroll
        for (int j = 0; j < 16; ++j) S[i][j] = (init == 1) ? ((4 * vg + i == 16 * ks + j) ? 1.f : 0.f) : 0.f;
    if (init == 2) {
#pragma unroll
        for (int i = 0; i < 4; ++i)
#pragma unroll
            for (int q = 0; q < 4; ++q) { const f32x4 v = *(const f32x4*)(initp + (4 * vg + i) * 64 + 16 * ks + 4 * q); S[i][4 * q] = v.x; S[i][4 * q + 1] = v.y; S[i][4 * q + 2] = v.z; S[i][4 * q + 3] = v.w; }
    }
    for (int s0 = 0; s0 < T; s0 += SCAN_BLK) {
#pragma unroll 1
        for (int s = 0; s < SCAN_BLK; ++s) {
            const int row = dir == 0 ? row_first + s0 + s : row_first + T - 1 - (s0 + s);
            const float r = bf2f(Rb[(size_t)row * DM + ch]), k = bf2f(Kb[(size_t)row * DM + ch]), v = bf2f(Vb[(size_t)row * DM + ch]);
            const float tw = bf2f(T2[(size_t)row * 256 + dir * 64 + lane]), ta = bf2f(T2[(size_t)row * 256 + 128 + dir * 64 + lane]);
            float wpre = 0.f, apre = 0.f;
#pragma unroll 8
            for (int j = 0; j < 64; ++j) { wpre = fmaf(RDL(tw, j), w2p[(size_t)j * DM], wpre); apre = fmaf(RDL(ta, j), a2p[(size_t)j * DM], apre); }
            const float w = __expf(-0.6065306597126334f * sigmoidf_(w0c + wpre));
            const float a = sigmoidf_(a0c + apre);
            const float kkr = k * kkc; const float nrm = sqrtf(wave_sum(kkr * kkr)); const float kk = kkr / fmaxf(nrm, 1e-12f);
            const float kd = k * (1.0f + (a - 1.0f) * kac);
            const float bsum = wave_sum(r * kd * rkc);
            if (bon && lane == 0) bon[(size_t)row * 16 + h] = bsum;
            LAS float* o = opb + s * 384;
            o[lane] = -kk; o[64 + lane] = w; o[128 + lane] = kk * a; o[192 + lane] = kd; o[256 + lane] = r; o[320 + lane] = hasv ? v : 0.f;
        }
        asm volatile("s_waitcnt lgkmcnt(0)" ::: "memory");
#pragma unroll 1
        for (int s = 0; s < SCAN_BLK; ++s) {
            const int row = dir == 0 ? row_first + s0 + s : row_first + T - 1 - (s0 + s);
            const LAS float* o = opb + s * 384;
            float av[16], wv[16], bv[16], kv[16], rv[16];
#pragma unroll
            for (int q = 0; q < 4; ++q) {
                const f32x4 x0 = *(const LAS f32x4*)(o + 16 * ks + 4 * q), x1 = *(const LAS f32x4*)(o + 64 + 16 * ks + 4 * q), x2 = *(const LAS f32x4*)(o + 128 + 16 * ks + 4 * q),
                            x3 = *(const LAS f32x4*)(o + 192 + 16 * ks + 4 * q), x4 = *(const LAS f32x4*)(o + 256 + 16 * ks + 4 * q);
                av[4 * q] = x0.x; av[4 * q + 1] = x0.y; av[4 * q + 2] = x0.z; av[4 * q + 3] = x0.w;
                wv[4 * q] = x1.x; wv[4 * q + 1] = x1.y; wv[4 * q + 2] = x1.z; wv[4 * q + 3] = x1.w;
                bv[4 * q] = x2.x; bv[4 * q + 1] = x2.y; bv[4 * q + 2] = x2.z; bv[4 * q + 3] = x2.w;
                kv[4 * q] = x3.x; kv[4 * q + 1] = x3.y; kv[4 * q + 2] = x3.z; kv[4 * q + 3] = x3.w;
                rv[4 * q] = x4.x; rv[4 * q + 1] = x4.y; rv[4 * q + 2] = x4.z; rv[4 * q + 3] = x4.w;
            }
            const f32x4 vv4 = *(const LAS f32x4*)(o + 320 + 4 * vg); const float vv[4] = {vv4.x, vv4.y, vv4.z, vv4.w};
            float y[4];
#pragma unroll
            for (int i = 0; i < 4; ++i) {
                float sa = 0.f;
#pragma unroll
                for (int j = 0; j < 16; ++j) sa = fmaf(S[i][j], av[j], sa);
                sa += dpp_x1(sa); sa += dpp_x2(sa);
                float yy = 0.f;
#pragma unroll
                for (int j = 0; j < 16; ++j) { S[i][j] = fmaf(S[i][j], wv[j], fmaf(sa, bv[j], vv[i] * kv[j])); yy = fmaf(S[i][j], rv[j], yy); }
                yy += dpp_x1(yy); yy += dpp_x2(yy); y[i] = yy;
            }
            const float yo = ks == 0 ? y[0] : ks == 1 ? y[1] : ks == 2 ? y[2] : y[3];
            yout[(size_t)row * DM + h * 64 + lane] = (bf16_t)f2bf(yo);
        }
        asm volatile("s_waitcnt lgkmcnt(0)" ::: "memory");
    }
    if (endp) {
#pragma unroll
        for (int i = 0; i < 4; ++i)
#pragma unroll
            for (int q = 0; q < 4; ++q) *(f32x4*)(endp + (4 * vg + i) * 64 + 16 * ks + 4 * q) = (f32x4){S[i][4 * q], S[i][4 * q + 1], S[i][4 * q + 2], S[i][4 * q + 3]};
    }
}
__device__ __forceinline__ void phase_rw_scan_seq(const Ctx& C) {
    unsigned char* ws = C.a->ws; bf16_t* Y = (bf16_t*)(ws + WS_H + R_Y); float* BON = (float*)(ws + WS_H + R_BON);
    for (int it = C.gw; it < 1088; it += C.NGW) {
        if (it < 64) { const int b = it >> 5, h = (it >> 1) & 15, dir = it & 1;
            scan_item(C, NPR + b * 4096, 4096, h, dir, 2, C.a->in[I_SWKV] + ((size_t)(b * 2 + dir) * 16 + h) * 4096, true, Y + (size_t)dir * MROWS * DM, nullptr, BON + (size_t)dir * MROWS * 16);
        } else { const int q = it - 64, b = q >> 5, h = (q >> 1) & 15, dir = q & 1;
            scan_item(C, b * 256, 256, h, dir, 0, nullptr, true, Y + (size_t)dir * MROWS * DM, C.a->out + OUT_WKV + ((size_t)(b * 2 + dir) * 16 + h) * 4096, BON + (size_t)dir * MROWS * 16); }
    }
}
__device__ __forceinline__ void phase_rw_post(const Ctx& C) {
    unsigned char* ws = C.a->ws; bf16_t* Y0 = (bf16_t*)(ws + WS_H + R_Y); const bf16_t* Y1 = Y0 + (size_t)MROWS * DM; const float* BON = (const float*)(ws + WS_H + R_BON);
    const bf16_t* Vb = (const bf16_t*)(ws + WS_H + R_V); const bf16_t* G = (const bf16_t*)(ws + WS_H + R_G);
    const float* lg = C.a->in[I_LNXG]; const float* lb = C.a->in[I_LNXB]; const int lane = C.lane;
    for (int it = C.gw; it < MROWS * 16; it += C.NGW) {
        const int row = it >> 4, h = it & 15, c = h * 64 + lane; const size_t e = (size_t)row * DM + c;
        const float y = bf2f(Y0[e]) + bf2f(Y1[e]);
        const float mean = wave_sum(y) * (1.f / 64.f); const float d = y - mean; const float var = wave_sum(d * d) * (1.f / 64.f);
        const float yn = d * (1.0f / sqrtf(var + 64e-5f)) * lg[c] + lb[c];
        const float bonus = (BON[(size_t)row * 16 + h] + BON[(size_t)MROWS * 16 + (size_t)row * 16 + h]) * bf2f(Vb[e]);
        Y0[e] = (bf16_t)f2bf((yn + bonus) * bf2f(G[e]));
    }
}

__device__ __forceinline__ void phase_pool_prep(const Ctx& C, int layer) {
    unsigned char* ws = C.a->ws; const float* X = (const float*)(ws + WS_X); bf16_t* P = (bf16_t*)(ws + WS_SCR + S_POOL); const float* MOD = (const float*)(ws + WS_MOD);
    const int lane = C.lane;
    for (int row = C.gw; row < MROWS; row += C.NGW) {
        int t, T; if (row < NPR) { t = row & 255; T = 256; } else { t = (row - NPR) & 4095; T = 4096; }
        const float* sc = modp(MOD, layer, cond_of_row(row), 1); const float* xr = X + (size_t)row * DM;
#pragma unroll
        for (int j = 0; j < 4; ++j) { const int c = 4 * lane + 256 * j; const int win = 2 << j;
            int lo = t - win / 2, hi = t - win / 2 + win; lo = lo < 0 ? 0 : lo; hi = hi > T ? T : hi;
            f32x4 s = (f32x4){0.f, 0.f, 0.f, 0.f};
            for (int u = lo; u < hi; ++u) s = s + *(const f32x4*)(xr + (ptrdiff_t)(u - t) * DM + c);
            const f32x4 o = (*(const f32x4*)(sc + c) + 1.0f) * (s * (1.0f / (float)(hi - lo)) - *(const f32x4*)(xr + c));
            u32x2 w; w.x = pk2(o.x, o.y); w.y = pk2(o.z, o.w); *(u32x2*)(P + (size_t)row * DM + c) = w; }
    }
}
#ifndef MK_MULTI
#define MK_MULTI 0
#endif
constexpr int NPHASES = 38;

__global__ void __launch_bounds__(NWAVES * 64, 2) mega_fwd(Args args) {
    extern __shared__ __attribute__((aligned(16))) unsigned char lds_raw[];
    Ctx C; C.a = &args; C.lds = (LAS unsigned char*)lds_raw;
    C.tid = threadIdx.x; C.lane = C.tid & 63; C.wave = __builtin_amdgcn_readfirstlane(C.tid >> 6);
    C.gw = blockIdx.x * NWAVES + C.wave; C.NGW = gridDim.x * NWAVES;
    volatile LAS unsigned* MISC = (volatile LAS unsigned*)(C.lds + MISC_OFF);
    if (C.tid < 32) MISC[C.tid] = 0u;
    __syncthreads();
    unsigned char* ws = args.ws;
    unsigned* ctl = (unsigned*)(ws + WS_CTL);
    XcdBarrier bar; bar.bar = ctl + CW_BAR; bar.x = 0; bar.st = MISC + 8;
    if (!MK_MULTI) bar = xcd_barrier_post(ctl + CW_BAR, MISC + 8);
    const int lo = args.ph_lo, hi = args.ph_hi; int ph = 0;
#define PHASE(body) do { if (ph >= lo && ph < hi) { body; if (!MK_MULTI && ph + 1 < hi) xcd_barrier(bar); else __syncthreads(); } ++ph; } while (0)

    bf16_t* WB = (bf16_t*)(ws + WS_W); float* X = (float*)(ws + WS_X); const bf16_t* H = (const bf16_t*)(ws + WS_H); const float* MOD = (const float*)(ws + WS_MOD);
    PHASE(phase0(C));
    PHASE(phase_init(C));
#define DO_LAYER(layer) do { \
        const int kind = layer % 3, j = layer / 3; \
        if (kind == 0) { \
            unsigned char* wm = (unsigned char*)WB + W_MLA + j * W_MLA_STRIDE; \
            PHASE(gemm_simple(C, ASelPlain{H}, 1024, (const bf16_t*)(wm + W_MLA_1), 1024, MROWS, 768, 1024, EpiF32{(float*)(ws + WS_SCR + S_R1), 768})); \
            PHASE(phase_mla_norm(C, j)); \
            PHASE(gemm_simple(C, ASelPlain{(const bf16_t*)(ws + WS_SCR + S_QA)}, 384, (const bf16_t*)(wm + W_MLA_QB), 384, MROWS, 1536, 384, EpiBf16{(bf16_t*)(ws + WS_SCR + S_Q), 1536}); \
                  gemm_simple(C, ASelPlain{(const bf16_t*)(ws + WS_SCR + S_CKV)}, 256, (const bf16_t*)(wm + W_MLA_KVB), 256, KVR, 2048, 256, EpiBf16{(bf16_t*)(ws + WS_SCR + S_KV), 2048})); \
            PHASE(phase_attn_simple(C)); \
            PHASE(gemm_simple(C, ASelPlain{(const bf16_t*)(ws + WS_SCR + S_O)}, 1024, (const bf16_t*)(wm + W_MLA_O), 1024, MROWS, 1024, 1024, EpiResid{X, MOD, layer, 2, nullptr})); \
        } else if (kind == 1) { \
            unsigned char* wr = (unsigned char*)WB + W_RW; const bf16_t* XA = (const bf16_t*)(ws + WS_H + R_XA); \
            PHASE(phase_rw_prep(C, layer, 0)); \
            PHASE(gemm_simple(C, ASelShift{XA, 10, (size_t)MROWS * DM}, 1024, (const bf16_t*)(wr + W_RW_1), 1024, MROWS, 3072, 1024, EpiRwA{(bf16_t*)(ws + WS_H + R_R)})); \
            PHASE(phase_rw_prep(C, layer, 1)); \
            PHASE(gemm_simple(C, ASelShift{XA, 8, (size_t)MROWS * DM}, 1024, (const bf16_t*)(wr + W_RW_1) + (size_t)3072 * 1024, 1024, MROWS, 768, 1024, EpiRwB{(bf16_t*)(ws + WS_H + R_T2), (bf16_t*)(ws + WS_H + R_SG)})); \
            PHASE(phase_rw_scan_seq(C)); \
            PHASE(gemm_simple(C, ASelPlain{(const bf16_t*)(ws + WS_H + R_SG)}, 256, (const bf16_t*)(wr + W_RW_G2T), 256, MROWS, 1024, 256, EpiBf16{(bf16_t*)(ws + WS_H + R_G), 1024})); \
            PHASE(phase_rw_post(C)); \
            PHASE(gemm_simple(C, ASelPlain{(const bf16_t*)(ws + WS_H + R_Y)}, 1024, (const bf16_t*)(wr + W_RW_O), 1024, MROWS, 1024, 1024, EpiResid{X, MOD, layer, 2, nullptr})); \
        } else { \
            PHASE(phase_pool_prep(C, layer)); \
            PHASE(gemm_simple(C, ASelShift{(const bf16_t*)(ws + WS_SCR + S_POOL), 8, (size_t)256}, 1024, (const bf16_t*)((unsigned char*)WB + W_POOL), 256, MROWS, 1024, 256, EpiResid{X, MOD, layer, 2, args.in[I_POOLS]})); \
        } \
        PHASE(phase_ln(C, layer, 0, layer, 3, false)); \
        PHASE(gemm_simple(C, ASelPlain{H}, 1024, (const bf16_t*)((unsigned char*)WB + layer * W_FFN_STRIDE + W_FFN_GU), 1024, MROWS, 5632, 1024, EpiSwiglu{(bf16_t*)(ws + WS_SCR + S_ACT)})); \
        PHASE(gemm_simple(C, ASelPlain{(const bf16_t*)(ws + WS_SCR + S_ACT)}, 2816, (const bf16_t*)((unsigned char*)WB + layer * W_FFN_STRIDE + W_FFN_D), 2816, MROWS, 1024, 2816, EpiResid{X, MOD, layer, 5, nullptr})); \
        PHASE(phase_ln(C, layer, 1, layer + 1, (layer == 2) ? 0 : -1, layer == 3)); \
     \
} while (0)
    DO_LAYER(0); DO_LAYER(1); DO_LAYER(2); DO_LAYER(3);
    if (!MK_MULTI && xb_ld(ctl + CW_BAR + XB_TMO) != 0u && blockIdx.x == 0 && C.tid == 0) args.out[0] = __builtin_nanf("");
}

extern "C" void kernel_launch(void* const* d_in, const int* in_sizes, int n_in, void* d_out, int out_size, void* d_ws, size_t ws_size, hipStream_t stream) {
    static int grid = 0;
    if (grid == 0) {
        int dev = 0, cus = 0, per_cu = 0;
        if (hipGetDevice(&dev) != hipSuccess || hipDeviceGetAttribute(&cus, hipDeviceAttributeMultiprocessorCount, dev) != hipSuccess) grid = -1;
        else if (hipFuncSetAttribute((const void*)mega_fwd, hipFuncAttributeMaxDynamicSharedMemorySize, LDS_BYTES) != hipSuccess) grid = -1;
        else {
            if (hipOccupancyMaxActiveBlocksPerMultiprocessor(&per_cu, (const void*)mega_fwd, NWAVES * 64, LDS_BYTES) != hipSuccess || per_cu < 1) { fprintf(stderr, "occupancy query: %d\n", per_cu); grid = -1; }
            else grid = cus;
            (void)hipGetLastError();
        }
        if (n_in != 41 || out_size != OUT_TOTAL || ws_size < WS_END) { fprintf(stderr, "kernel_launch: unexpected n_in %d out %d ws %zu\n", n_in, out_size, ws_size); grid = -2; }
    }
    if (grid == -2) { (void)hipMemsetAsync(d_out, 0xFF, (size_t)out_size * 4, stream); return; }
    if (grid < 0) return;
    (void)hipMemsetAsync((char*)d_ws + WS_CTL, 0, CTL_ZERO_BYTES, stream);
    Args a{};
    for (int i = 0; i < 41; ++i) a.in[i] = (const float*)d_in[i];
    a.out = (float*)d_out; a.ws = (unsigned char*)d_ws;
#if MK_MULTI
    for (int p = 0; p < NPHASES; ++p) { a.ph_lo = p; a.ph_hi = p + 1; hipLaunchKernelGGL(mega_fwd, dim3(grid), dim3(NWAVES * 64), LDS_BYTES, stream, a); }
#else
    a.ph_lo = 0; a.ph_hi = NPHASES;
    void* kargs[] = {&a};
    hipError_t e = hipLaunchCooperativeKernel((const void*)mega_fwd, dim3(grid), dim3(NWAVES * 64), kargs, LDS_BYTES, stream);
    if (e != hipSuccess) fprintf(stderr, "cooperative launch failed: %s (grid %d)\n", hipGetErrorString(e), grid);
#endif
}
```

```cpp
#include <hip/hip_runtime.h>
#include <cstdio>
#include <cstdint>

#define GAS __attribute__((address_space(1)))
#define LAS __attribute__((address_space(3)))
typedef unsigned short bf16_t;
typedef float f32x4 __attribute__((ext_vector_type(4)));
typedef float f32x2 __attribute__((ext_vector_type(2)));
typedef unsigned u32x4 __attribute__((ext_vector_type(4)));
typedef unsigned u32x2 __attribute__((ext_vector_type(2)));
typedef short bf16x8 __attribute__((ext_vector_type(8)));

constexpr int DM = 1024, NPR = 8192, MROWS = 16384, DFF = 2816, NHEAD = 16;
constexpr int KVR = 17408;
constexpr float ALPHA = 1.681792830507429f;
constexpr int OUT_YP = 0, OUT_YS = 8388608, OUT_CKV = 16777216, OUT_KPE = 20971520, OUT_WKV = 21495808, OUT_TOTAL = 25690112;

constexpr size_t MiB = 1u << 20;
constexpr size_t WS_CTL = 0, CTL_ZERO_BYTES = 1 * MiB;
constexpr size_t WS_MOD = 1 * MiB;
constexpr size_t WS_ROPE = WS_MOD + 512 * 1024;
constexpr size_t WS_BON = WS_MOD + 576 * 1024;
constexpr size_t WS_W = 2 * MiB;
constexpr size_t W_FFN_GU = 0, W_FFN_D = 11 * MiB, W_FFN_STRIDE = 16 * MiB + 512 * 1024;
constexpr size_t W_MLA = 66 * MiB, W_MLA_STRIDE = 6 * MiB;
constexpr size_t W_MLA_1 = 0, W_MLA_QB = 1536 * 1024, W_MLA_KVB = 1536 * 1024 + 1152 * 1024, W_MLA_O = 1536 * 1024 + 1152 * 1024 + 1024 * 1024;
constexpr size_t W_RW = 78 * MiB;
constexpr size_t W_RW_1 = 0, W_RW_G2T = 7 * MiB + 512 * 1024, W_RW_O = 8 * MiB, W_RW_W2T = 10 * MiB, W_RW_A2T = 10 * MiB + 256 * 1024;
constexpr size_t W_POOL = 91 * MiB;
constexpr size_t WS_X = 94 * MiB;
constexpr size_t WS_H = 158 * MiB;
constexpr size_t WS_SCR = 190 * MiB;
constexpr size_t WS_END = 384 * MiB;
constexpr size_t S_R1 = 0, S_Q = 0, S_KV = 48 * MiB, S_O = 116 * MiB, S_QA = 148 * MiB, S_CKV = 160 * MiB, S_KPE = 169 * MiB;
constexpr size_t S_ACT = 0;
constexpr size_t S_POOL = 0;
constexpr size_t R_XA = 0, R_R = 96 * MiB, R_K = 128 * MiB, R_V = 160 * MiB, R_T2 = 192 * MiB, R_SG = 200 * MiB, R_Y = 0, R_QT = 64 * MiB, R_EP = 208 * MiB, R_BON = 224 * MiB, R_G = 96 * MiB, R_SS = 128 * MiB;

constexpr int NWAVES = 8;
constexpr int LDS_BYTES = 147456;
constexpr int MISC_OFF = LDS_BYTES - 128;
constexpr int CW_BAR = 4096;

__device__ __forceinline__ unsigned f2bf(float f) { unsigned u = __builtin_bit_cast(unsigned, f); return (u + 0x7fffu + ((u >> 16) & 1u)) >> 16; }
typedef __bf16 bf16x2_t __attribute__((ext_vector_type(2)));
__device__ __forceinline__ unsigned pk2(float lo, float hi) { const f32x2 v = {lo, hi}; const bf16x2_t b = __builtin_convertvector(v, bf16x2_t); return __builtin_bit_cast(unsigned, b); }
__device__ __forceinline__ float bf2f(unsigned short b) { return __builtin_bit_cast(float, (unsigned)b << 16); }
__device__ __forceinline__ float bflo(unsigned w) { return __builtin_bit_cast(float, w << 16); }
__device__ __forceinline__ float bfhi(unsigned w) { return __builtin_bit_cast(float, w & 0xffff0000u); }
__device__ __forceinline__ float wave_sum(float v) {
#pragma unroll
    for (int o = 1; o < 64; o <<= 1) v += __shfl_xor(v, o);
    return v;
}
__device__ __forceinline__ float wave_max(float v) {
#pragma unroll
    for (int o = 1; o < 64; o <<= 1) v = fmaxf(v, __shfl_xor(v, o));
    return v;
}
__device__ __forceinline__ float sigmoidf_(float x) { return 1.0f / (1.0f + __expf(-x)); }
__device__ __forceinline__ float siluf_(float x) { return x / (1.0f + __expf(-x)); }
__device__ __forceinline__ int cond_of_row(int row) { return row < NPR ? 0 : 1 + ((row - NPR) >> 12); }
__device__ __forceinline__ const float* modp(const float* MOD, int layer, int cond, int j) { return MOD + (size_t)((layer * 3 + cond) * 6 + j) * DM; }
__device__ __forceinline__ int perm32(int rho) { const int n = rho >> 4, i = rho & 15; return 8 * (i >> 2) + 4 * n + (i & 3); }

#define XB_TMO      128
#define XB_XCNT(j)  (256  + 64 * (j))
#define XB_XSUB(j)  (1280 + 64 * (j))
#define XB_XGEN(j)  (2304 + 64 * (j))
#define XB_TOP      3328
#define XB_TOPGEN   3392
#define XCD_BAR_WORDS 3456
#define XB_SPIN_CAP (1u << 18)
__device__ __forceinline__ unsigned xb_ld(unsigned* p)              { return __hip_atomic_load(p, __ATOMIC_RELAXED, __HIP_MEMORY_SCOPE_AGENT); }
__device__ __forceinline__ unsigned xb_add(unsigned* p, unsigned v) { return __hip_atomic_fetch_add(p, v, __ATOMIC_RELAXED, __HIP_MEMORY_SCOPE_AGENT); }
__device__ __forceinline__ unsigned xb_xcc_id() { return (unsigned)__builtin_amdgcn_s_getreg((3 << 11) | 20) & 0xFu; }
#define XB_SPIN(cond, bar) do { unsigned _sp = 0; while (cond) { __builtin_amdgcn_s_sleep(1); \
    if ((++_sp & 255u) == 0u) { if (xb_ld(&(bar)[XB_TMO])) break; if (_sp > XB_SPIN_CAP) { atomicAdd(&(bar)[XB_TMO], 1u); break; } } } } while (0)
struct XcdBarrier { unsigned* bar; unsigned x; volatile LAS unsigned* st; };
__device__ __forceinline__ XcdBarrier xcd_barrier_post(unsigned* bar, volatile LAS unsigned* st) {
    XcdBarrier b; b.bar = bar; b.x = xb_xcc_id(); b.st = st;
    if (threadIdx.x == 0) (void)xb_add(&bar[XB_XCNT(b.x)], 1u);
    return b;
}
__device__ __forceinline__ void xcd_barrier_complete(unsigned* bar, unsigned x, unsigned& nloc, unsigned& nx) {
    const unsigned G = gridDim.x * gridDim.y * gridDim.z;
    unsigned sum, cnt, mine, sp = 0u;
    for (;;) {
        sum = 0u; cnt = 0u; mine = 0u;
#pragma unroll
        for (unsigned j = 0; j < 16; ++j) { const unsigned c = xb_ld(&bar[XB_XCNT(j)]); sum += c; cnt += (c > 0u) ? 1u : 0u; mine = (j == x) ? c : mine; }
        if (sum == G) break;
        __builtin_amdgcn_s_sleep(1);
        if ((++sp & 255u) == 0u) { if (xb_ld(&bar[XB_TMO])) break; if (sp > XB_SPIN_CAP) { atomicAdd(&bar[XB_TMO], 1u); break; } }
    }
    nloc = mine > 0u ? mine : 1u; nx = cnt > 0u ? cnt : 1u;
}
__device__ __forceinline__ void xcd_barrier(const XcdBarrier& b) {
    asm volatile("s_waitcnt vmcnt(0)" ::: "memory");
    __syncthreads();
    if (threadIdx.x == 0) {
        unsigned* bar = b.bar;
        __builtin_amdgcn_s_waitcnt(0);
        unsigned nloc = b.st[0], nx = b.st[1];
        if (nloc == 0u) { xcd_barrier_complete(bar, b.x, nloc, nx); b.st[0] = nloc; b.st[1] = nx; }
        const unsigned old = xb_add(&bar[XB_XSUB(b.x)], 1u);
        const unsigned gen = old / nloc;
        if (old + 1u == (gen + 1u) * nloc) {
            __builtin_amdgcn_fence(__ATOMIC_RELEASE, "agent");
            asm volatile("s_waitcnt vmcnt(0)" ::: "memory");
            const unsigned og = xb_add(&bar[XB_TOP], 1u);
            const unsigned tg = og / nx;
            if (og + 1u == (tg + 1u) * nx) xb_add(&bar[XB_TOPGEN], 1u);
            else XB_SPIN(xb_ld(&bar[XB_TOPGEN]) == tg, bar);
            __builtin_amdgcn_fence(__ATOMIC_ACQUIRE, "agent");
            xb_add(&bar[XB_XGEN(b.x)], 1u);
            asm volatile("s_waitcnt vmcnt(0)" ::: "memory");
        } else {
            XB_SPIN(xb_ld(&bar[XB_XGEN(b.x)]) == gen, bar);
            __builtin_amdgcn_fence(__ATOMIC_ACQUIRE, "agent");
            asm volatile("s_waitcnt vmcnt(0)" ::: "memory");
        }
    }
    __syncthreads();
}
struct Args { const float* in[41]; float* out; unsigned char* ws; int ph_lo, ph_hi; };
enum { I_XP = 0, I_XS, I_CCKV, I_CKPE, I_SWKV, I_C, I_CCTX, I_ADAW, I_ADAB, I_LNG, I_LNB, I_WG, I_WU, I_WD, I_WQA, I_QNORM, I_WQB, I_WKVA, I_KVNORM, I_WKVB, I_MWO,
       I_MU, I_WR, I_WK, I_WV, I_W0, I_W1, I_W2, I_A0, I_A1, I_A2, I_G1, I_G2, I_KK, I_KA, I_RK, I_LNXG, I_LNXB, I_RWO, I_POOLW, I_POOLS };

struct Ctx {
    const Args* a;
    LAS unsigned char* lds;
    int tid, lane, wave, gw, NGW;
};

enum { MAP_ID = 0, MAP_GU = 1, MAP_QB = 2, MAP_KVA = 3 };
__device__ __forceinline__ int map_row(int map, int mp, int n) {
    if (map == MAP_ID) return mp + n;
    if (map == MAP_GU) return (n >> 2) * 8 + mp * 4 + (n & 3);
    if (map == MAP_QB) { const int h = n / 96, d = n - h * 96; if (d < 64) return n; const int i = d - 64; return h * 96 + 64 + (i & 16) + ((i & 7) << 1) + ((i >> 3) & 1); }
           { if (n < 256) return 384 + n; const int i = n - 256; return 640 + (i & 16) + ((i & 7) << 1) + ((i >> 3) & 1); }
}
__device__ __forceinline__ void conv_tile(const float* W, int ldw, int nblk, int tile, bf16_t* WT, int ldk, int koff, int map, int mp, LAS float* scr, int lane) {
    const int kb = tile / nblk, nb = tile - kb * nblk, k0 = 64 * kb, n0 = 32 * nb;
#pragma unroll 8
    for (int i = 0; i < 32; ++i) { const int kk = 2 * i + (lane >> 5); scr[kk * 33 + (lane & 31)] = W[(size_t)(k0 + kk) * ldw + n0 + (lane & 31)]; }
    asm volatile("s_waitcnt lgkmcnt(0)" ::: "memory");
    const int c = lane & 7;
#pragma unroll
    for (int j = 0; j < 4; ++j) { const int n = (lane >> 3) + 8 * j; const LAS float* s = scr + (8 * c) * 33 + n;
        u32x4 o; o.x = pk2(s[0 * 33], s[1 * 33]); o.y = pk2(s[2 * 33], s[3 * 33]); o.z = pk2(s[4 * 33], s[5 * 33]); o.w = pk2(s[6 * 33], s[7 * 33]);
        *(u32x4*)(WT + (size_t)map_row(map, mp, n0 + n) * ldk + koff + k0 + 8 * c) = o; }
    asm volatile("s_waitcnt lgkmcnt(0)" ::: "memory");
}
__device__ __forceinline__ void zero_rect_item(bf16_t* Wt, int ld, int r0, int c0, int nc, int item, int lane) {
    const int cpr = nc >> 3; const int idx = item * 64 + lane; const int r = idx / cpr, c = idx - r * cpr;
    *(u32x4*)(Wt + (size_t)(r0 + r) * ld + c0 + 8 * c) = (u32x4){0u, 0u, 0u, 0u};
}
__device__ __forceinline__ void adaln_item(const Ctx& C, int item, float* MOD) {
    const int layer = item / 96, cg = item - layer * 96, col = cg * 64 + C.lane;
    const float* W = C.a->in[I_ADAW] + (size_t)layer * DM * 6144 + col;
    const float* cx = C.a->in[I_CCTX]; const float* c0 = C.a->in[I_C]; const float* c1 = c0 + DM;
    float a0 = 0.f, a1 = 0.f, a2 = 0.f;
    for (int kb = 0; kb < DM; kb += 64) {
        const float s0 = siluf_(cx[kb + C.lane]), s1 = siluf_(c0[kb + C.lane]), s2 = siluf_(c1[kb + C.lane]);
#pragma unroll
        for (int kk = 0; kk < 64; ++kk) {
            const float w = W[(size_t)(kb + kk) * 6144];
            a0 = fmaf(__builtin_bit_cast(float, __builtin_amdgcn_readlane(__builtin_bit_cast(int, s0), kk)), w, a0);
            a1 = fmaf(__builtin_bit_cast(float, __builtin_amdgcn_readlane(__builtin_bit_cast(int, s1), kk)), w, a1);
            a2 = fmaf(__builtin_bit_cast(float, __builtin_amdgcn_readlane(__builtin_bit_cast(int, s2), kk)), w, a2);
        }
    }
    const float b = C.a->in[I_ADAB][layer * 6144 + col];
    MOD[(size_t)(layer * 3 + 0) * 6144 + col] = a0 + b;
    MOD[(size_t)(layer * 3 + 1) * 6144 + col] = a1 + b;
    MOD[(size_t)(layer * 3 + 2) * 6144 + col] = a2 + b;
}
__device__ __forceinline__ void rope_tables(float* ROPE, int t) {
    if (t >= 8) return;
    const double invf[8] = {1.0, 0.31622776601683794, 0.1, 0.031622776601683794, 0.01, 0.0031622776601683794, 0.001, 0.00031622776601683794};
    double th = 1.0;
#pragma unroll
    for (int f = 0; f < 8; ++f) th = (t == f) ? invf[f] : th;
    double s = 0.0, c = 0.0, term = 1.0;
#pragma unroll
    for (int n = 0; n < 22; ++n) { if ((n & 1) == 0) c += ((n & 2) ? -term : term); else s += ((n & 2) ? -term : term); term = term * th / (double)(n + 1); }
    double cr = 1.0, sr = 0.0;
    for (int p = 0; p < 64; ++p) { ROPE[p * 8 + t] = (float)cr; ROPE[512 + p * 8 + t] = (float)sr; const double c2 = cr * c - sr * s, s2 = sr * c + cr * s; cr = c2; sr = s2; }
}

#define JOB(n, call) { const int _n = (n); if (r < _n) { call; continue; } r -= _n; }
__device__ __forceinline__ void phase0(const Ctx& C) {
    unsigned char* ws = C.a->ws; bf16_t* WB = (bf16_t*)(ws + WS_W);
    LAS float* scr = (LAS float*)(C.lds + C.wave * 16384);
    float* MOD = (float*)(ws + WS_MOD);
    if (C.gw == 0) rope_tables((float*)(ws + WS_ROPE), C.lane);
    const float* const* in = C.a->in;
    constexpr int T_GU = (1024 / 64) * (2816 / 32), T_D = (2816 / 64) * (1024 / 32);
    constexpr int T_QA = 16 * 12, T_KVA = 16 * 9, T_QB = 6 * 48, T_KVB = 4 * 64, T_SQ = 16 * 32, T_W1 = 16 * 2, T_G1 = 16 * 4, T_G2 = 2 * 32, T_PW = 4 * 8, T_W2 = 1 * 32;
    constexpr int N_ADA = 4 * 96;
    constexpr int TOTAL = N_ADA + 4 * (2 * T_GU + T_D) + 2 * (T_QA + T_KVA + T_QB + T_KVB + T_SQ) + 3 * T_SQ + 4 * T_W1 + T_G1 + T_G2 + T_SQ + 4 * T_PW + 4 * T_W2
                        + 2 * (96 * 1024 / 8 / 64) + 3 * (128 * 1024 / 8 / 64) + (1024 * 128 / 8 / 64);
    for (int it = C.gw; it < TOTAL; it += C.NGW) {
        int r = it;
        JOB(N_ADA, adaln_item(C, r, MOD));
        bool done = false;
#pragma unroll 1
        for (int L = 0; L < 4 && !done; ++L) {
            bf16_t* gu = (bf16_t*)((unsigned char*)WB + L * W_FFN_STRIDE + W_FFN_GU); bf16_t* wd = (bf16_t*)((unsigned char*)WB + L * W_FFN_STRIDE + W_FFN_D);
            if (r < T_GU) { conv_tile(in[I_WG] + (size_t)L * 1024 * 2816, 2816, 88, r, gu, 1024, 0, MAP_GU, 0, scr, C.lane); done = true; break; } r -= T_GU;
            if (r < T_GU) { conv_tile(in[I_WU] + (size_t)L * 1024 * 2816, 2816, 88, r, gu, 1024, 0, MAP_GU, 1, scr, C.lane); done = true; break; } r -= T_GU;
            if (r < T_D)  { conv_tile(in[I_WD] + (size_t)L * 2816 * 1024, 1024, 32, r, wd, 2816, 0, MAP_ID, 0, scr, C.lane); done = true; break; } r -= T_D;
        }
        if (done) continue;
#pragma unroll 1
        for (int j = 0; j < 2 && !done; ++j) {
            unsigned char* wm = (unsigned char*)WB + W_MLA + j * W_MLA_STRIDE;
            if (r < T_QA)  { conv_tile(in[I_WQA] + (size_t)j * 1024 * 384, 384, 12, r, (bf16_t*)(wm + W_MLA_1), 1024, 0, MAP_ID, 0, scr, C.lane); done = true; break; } r -= T_QA;
            if (r < T_KVA) { conv_tile(in[I_WKVA] + (size_t)j * 1024 * 288, 288, 9, r, (bf16_t*)(wm + W_MLA_1), 1024, 0, MAP_KVA, 0, scr, C.lane); done = true; break; } r -= T_KVA;
            if (r < T_QB)  { conv_tile(in[I_WQB] + (size_t)j * 384 * 1536, 1536, 48, r, (bf16_t*)(wm + W_MLA_QB), 384, 0, MAP_QB, 0, scr, C.lane); done = true; break; } r -= T_QB;
            if (r < T_KVB) { conv_tile(in[I_WKVB] + (size_t)j * 256 * 2048, 2048, 64, r, (bf16_t*)(wm + W_MLA_KVB), 256, 0, MAP_ID, 0, scr, C.lane); done = true; break; } r -= T_KVB;
            if (r < T_SQ)  { conv_tile(in[I_MWO] + (size_t)j * 1024 * 1024, 1024, 32, r, (bf16_t*)(wm + W_MLA_O), 1024, 0, MAP_ID, 0, scr, C.lane); done = true; break; } r -= T_SQ;
        }
        if (done) continue;
        unsigned char* wr = (unsigned char*)WB + W_RW;
        bf16_t* w1c = (bf16_t*)(wr + W_RW_1);
        JOB(T_SQ, conv_tile(in[I_WR], 1024, 32, r, w1c, 1024, 0, MAP_ID, 0, scr, C.lane));
        JOB(T_SQ, conv_tile(in[I_WK], 1024, 32, r, w1c, 1024, 0, MAP_ID, 1024, scr, C.lane));
        JOB(T_SQ, conv_tile(in[I_WV], 1024, 32, r, w1c, 1024, 0, MAP_ID, 2048, scr, C.lane));
        JOB(T_W1, conv_tile(in[I_W1], 64, 2, r, w1c, 1024, 0, MAP_ID, 3072, scr, C.lane));
        JOB(T_W1, conv_tile(in[I_W1] + 1024 * 64, 64, 2, r, w1c, 1024, 0, MAP_ID, 3072 + 64, scr, C.lane));
        JOB(T_W1, conv_tile(in[I_A1], 64, 2, r, w1c, 1024, 0, MAP_ID, 3328, scr, C.lane));
        JOB(T_W1, conv_tile(in[I_A1] + 1024 * 64, 64, 2, r, w1c, 1024, 0, MAP_ID, 3328 + 64, scr, C.lane));
        JOB(T_G1, conv_tile(in[I_G1], 128, 4, r, w1c, 1024, 0, MAP_ID, 3584, scr, C.lane));
        JOB(T_G2, conv_tile(in[I_G2], 1024, 32, r, (bf16_t*)(wr + W_RW_G2T), 256, 0, MAP_ID, 0, scr, C.lane));
        JOB(T_SQ, conv_tile(in[I_RWO], 1024, 32, r, (bf16_t*)(wr + W_RW_O), 1024, 0, MAP_ID, 0, scr, C.lane));
        JOB(T_PW, conv_tile(in[I_POOLW] + 0 * 65536, 256, 8, r, (bf16_t*)((unsigned char*)WB + W_POOL), 256, 0, MAP_ID, 0, scr, C.lane));
        JOB(T_PW, conv_tile(in[I_POOLW] + 1 * 65536, 256, 8, r, (bf16_t*)((unsigned char*)WB + W_POOL), 256, 0, MAP_ID, 256, scr, C.lane));
        JOB(T_PW, conv_tile(in[I_POOLW] + 2 * 65536, 256, 8, r, (bf16_t*)((unsigned char*)WB + W_POOL), 256, 0, MAP_ID, 512, scr, C.lane));
        JOB(T_PW, conv_tile(in[I_POOLW] + 3 * 65536, 256, 8, r, (bf16_t*)((unsigned char*)WB + W_POOL), 256, 0, MAP_ID, 768, scr, C.lane));
        JOB(T_W2, conv_tile(in[I_W2], 1024, 32, r, (bf16_t*)(wr + W_RW_W2T), 64, 0, MAP_ID, 0, scr, C.lane));
        JOB(T_W2, conv_tile(in[I_W2] + 64 * 1024, 1024, 32, r, (bf16_t*)(wr + W_RW_W2T), 64, 0, MAP_ID, 1024, scr, C.lane));
        JOB(T_W2, conv_tile(in[I_A2], 1024, 32, r, (bf16_t*)(wr + W_RW_A2T), 64, 0, MAP_ID, 0, scr, C.lane));
        JOB(T_W2, conv_tile(in[I_A2] + 64 * 1024, 1024, 32, r, (bf16_t*)(wr + W_RW_A2T), 64, 0, MAP_ID, 1024, scr, C.lane));
        JOB(96 * 1024 / 8 / 64, zero_rect_item((bf16_t*)((unsigned char*)WB + W_MLA + W_MLA_1), 1024, 672, 0, 1024, r, C.lane));
        JOB(96 * 1024 / 8 / 64, zero_rect_item((bf16_t*)((unsigned char*)WB + W_MLA + W_MLA_STRIDE + W_MLA_1), 1024, 672, 0, 1024, r, C.lane));
        JOB(128 * 1024 / 8 / 64, zero_rect_item(w1c, 1024, 3200, 0, 1024, r, C.lane));
        JOB(128 * 1024 / 8 / 64, zero_rect_item(w1c, 1024, 3456, 0, 1024, r, C.lane));
        JOB(128 * 1024 / 8 / 64, zero_rect_item(w1c, 1024, 3712, 0, 1024, r, C.lane));
        JOB(1024 * 128 / 8 / 64, zero_rect_item((bf16_t*)(wr + W_RW_G2T), 256, 0, 128, 128, r, C.lane));
    }
}

__device__ __forceinline__ void store_h_row(bf16_t* Hrow, const f32x4 (&x)[4], const float* sh, const float* sc, int lane) {
#pragma unroll
    for (int j = 0; j < 4; ++j) { const int c = 4 * lane + 256 * j; const f32x4 s = *(const f32x4*)(sc + c), t = *(const f32x4*)(sh + c);
        u32x2 o; o.x = pk2(x[j].x * (1.f + s.x) + t.x, x[j].y * (1.f + s.y) + t.y); o.y = pk2(x[j].z * (1.f + s.z) + t.z, x[j].w * (1.f + s.w) + t.w);
        *(u32x2*)(Hrow + c) = o; }
}
__device__ __forceinline__ void phase_init(const Ctx& C) {
    unsigned char* ws = C.a->ws; float* X = (float*)(ws + WS_X); bf16_t* H = (bf16_t*)(ws + WS_H); const float* MOD = (const float*)(ws + WS_MOD);
    for (int row = C.gw; row < MROWS; row += C.NGW) {
        const float* src = row < NPR ? C.a->in[I_XP] + (size_t)row * DM : C.a->in[I_XS] + (size_t)(row - NPR) * DM;
        f32x4 x[4];
#pragma unroll
        for (int j = 0; j < 4; ++j) { x[j] = *(const f32x4*)(src + 4 * C.lane + 256 * j); *(f32x4*)(X + (size_t)row * DM + 4 * C.lane + 256 * j) = x[j]; }
        const int cd = cond_of_row(row);
        store_h_row(H + (size_t)row * DM, x, modp(MOD, 0, cd, 0), modp(MOD, 0, cd, 1), C.lane);
    }
}
__device__ __forceinline__ void phase_ln(const Ctx& C, int layer, int which, int hl, int hs, bool to_out) {
    unsigned char* ws = C.a->ws; float* X = (float*)(ws + WS_X); bf16_t* H = (bf16_t*)(ws + WS_H); const float* MOD = (const float*)(ws + WS_MOD);
    const float* g = C.a->in[I_LNG] + (size_t)(layer * 2 + which) * DM; const float* b = C.a->in[I_LNB] + (size_t)(layer * 2 + which) * DM;
    for (int row = C.gw; row < MROWS; row += C.NGW) {
        float* xr = X + (size_t)row * DM; f32x4 x[4]; float s = 0.f;
#pragma unroll
        for (int j = 0; j < 4; ++j) { x[j] = *(const f32x4*)(xr + 4 * C.lane + 256 * j); s += (x[j].x + x[j].y) + (x[j].z + x[j].w); }
        const float mean = wave_sum(s) * (1.f / DM); float q = 0.f;
#pragma unroll
        for (int j = 0; j < 4; ++j) { x[j] = x[j] - mean; q += (x[j].x * x[j].x + x[j].y * x[j].y) + (x[j].z * x[j].z + x[j].w * x[j].w); }
        const float rstd = 1.0f / sqrtf(wave_sum(q) * (1.f / DM) + 1e-5f);
#pragma unroll
        for (int j = 0; j < 4; ++j) { const int c = 4 * C.lane + 256 * j; const f32x4 gg = *(const f32x4*)(g + c), bb = *(const f32x4*)(b + c);
            x[j] = x[j] * rstd * gg + bb; *(f32x4*)(xr + c) = x[j];
            if (to_out) *(f32x4*)(C.a->out + (size_t)row * DM + c) = x[j]; }
        if (hs >= 0) { const int cd = cond_of_row(row); store_h_row(H + (size_t)row * DM, x, modp(MOD, hl, cd, hs), modp(MOD, hl, cd, hs + 1), C.lane); }
    }
}

template <class ASel, class Epi>
__device__ __forceinline__ void gemm_simple(const Ctx& C, const ASel& asel, int lda, const bf16_t* Bt, int ldb, int Mr, int N, int K, const Epi& epi) {
    const int nTm = Mr >> 6, nTn = N >> 6, fr = C.lane & 15, fq = C.lane >> 4;
    for (int t = C.gw; t < nTm * nTn; t += C.NGW) {
        const int tm = t / nTn, tn = t - tm * nTn, m0 = tm * 64, n0 = tn * 64;
        const bf16_t* A = asel(n0);
        f32x4 acc[4][2][2];
#pragma unroll
        for (int mi = 0; mi < 4; ++mi)
#pragma unroll
            for (int g = 0; g < 2; ++g) { acc[mi][g][0] = (f32x4){0.f, 0.f, 0.f, 0.f}; acc[mi][g][1] = (f32x4){0.f, 0.f, 0.f, 0.f}; }
        const bf16_t* ap = A + (size_t)(m0 + fr) * lda + 8 * fq;
        const bf16_t* bp0 = Bt + (size_t)(n0 + perm32(fr)) * ldb + 8 * fq;
        const bf16_t* bp1 = Bt + (size_t)(n0 + perm32(16 + fr)) * ldb + 8 * fq;
        for (int k0 = 0; k0 < K; k0 += 32) {
            bf16x8 af[4], bf[2][2];
#pragma unroll
            for (int mi = 0; mi < 4; ++mi) af[mi] = *(const bf16x8*)(ap + (size_t)(16 * mi) * lda + k0);
#pragma unroll
            for (int g = 0; g < 2; ++g) { bf[g][0] = *(const bf16x8*)(bp0 + (size_t)(32 * g) * ldb + k0); bf[g][1] = *(const bf16x8*)(bp1 + (size_t)(32 * g) * ldb + k0); }
#pragma unroll
            for (int mi = 0; mi < 4; ++mi)
#pragma unroll
                for (int g = 0; g < 2; ++g) {
                    acc[mi][g][0] = __builtin_amdgcn_mfma_f32_16x16x32_bf16(bf[g][0], af[mi], acc[mi][g][0], 0, 0, 0);
                    acc[mi][g][1] = __builtin_amdgcn_mfma_f32_16x16x32_bf16(bf[g][1], af[mi], acc[mi][g][1], 0, 0, 0);
                }
        }
#pragma unroll
        for (int mi = 0; mi < 4; ++mi)
#pragma unroll
            for (int g = 0; g < 2; ++g) epi(m0 + 16 * mi + fr, n0 + 32 * g + 8 * fq, acc[mi][g][0], acc[mi][g][1]);
    }
}
struct ASelPlain { const bf16_t* A; __device__ __forceinline__ const bf16_t* operator()(int) const { return A; } };
struct ASelShift { const bf16_t* A; int shift; size_t stride; __device__ __forceinline__ const bf16_t* operator()(int n0) const { return A + (size_t)(n0 >> shift) * stride; } };

struct EpiF32 { float* out; int ldc;
    __device__ __forceinline__ void operator()(int row, int c0, f32x4 v0, f32x4 v1) const { float* o = out + (size_t)row * ldc + c0; *(f32x4*)o = v0; *(f32x4*)(o + 4) = v1; } };
struct EpiBf16 { bf16_t* out; int ldc;
    __device__ __forceinline__ void operator()(int row, int c0, f32x4 v0, f32x4 v1) const {
        u32x4 w; w.x = pk2(v0.x, v0.y); w.y = pk2(v0.z, v0.w); w.z = pk2(v1.x, v1.y); w.w = pk2(v1.z, v1.w); *(u32x4*)(out + (size_t)row * ldc + c0) = w; } };
struct EpiSwiglu { bf16_t* act;
    __device__ __forceinline__ void operator()(int row, int c0, f32x4 v0, f32x4 v1) const {
        u32x2 w; w.x = pk2(siluf_(v0.x) * v1.x, siluf_(v0.y) * v1.y); w.y = pk2(siluf_(v0.z) * v1.z, siluf_(v0.w) * v1.w);
        *(u32x2*)(act + (size_t)row * DFF + (c0 >> 1)) = w; } };
struct EpiResid { float* X; const float* MOD; int layer, gslot; const float* cscale;
    __device__ __forceinline__ void operator()(int row, int c0, f32x4 v0, f32x4 v1) const {
        const float* gt = modp(MOD, layer, cond_of_row(row), gslot) + c0; float* x = X + (size_t)row * DM + c0;
        f32x4 g0 = *(const f32x4*)gt, g1 = *(const f32x4*)(gt + 4);
        if (cscale) { g0 = g0 * *(const f32x4*)(cscale + c0); g1 = g1 * *(const f32x4*)(cscale + c0 + 4); }
        const f32x4 x0 = *(const f32x4*)x, x1 = *(const f32x4*)(x + 4);
        *(f32x4*)x = x0 * ALPHA + g0 * v0; *(f32x4*)(x + 4) = x1 * ALPHA + g1 * v1; } };
struct EpiRwA { bf16_t* R;
    __device__ __forceinline__ void operator()(int row, int c0, f32x4 v0, f32x4 v1) const {
        u32x4 w; w.x = pk2(v0.x, v0.y); w.y = pk2(v0.z, v0.w); w.z = pk2(v1.x, v1.y); w.w = pk2(v1.z, v1.w);
        *(u32x4*)(R + (size_t)(c0 >> 10) * ((size_t)MROWS * DM) + (size_t)row * DM + (c0 & 1023)) = w; } };
struct EpiRwB { bf16_t* T2; bf16_t* SG;
    __device__ __forceinline__ void operator()(int row, int c0, f32x4 v0, f32x4 v1) const {
        const int tile = c0 >> 8, cc = c0 & 255;
        if (tile == 0) { if (cc >= 128) return;
            u32x4 w; w.x = pk2(tanhf(v0.x), tanhf(v0.y)); w.y = pk2(tanhf(v0.z), tanhf(v0.w)); w.z = pk2(tanhf(v1.x), tanhf(v1.y)); w.w = pk2(tanhf(v1.z), tanhf(v1.w));
            *(u32x4*)(T2 + (size_t)row * 256 + cc) = w; }
        else if (tile == 1) { if (cc >= 128) return;
            u32x4 w; w.x = pk2(v0.x, v0.y); w.y = pk2(v0.z, v0.w); w.z = pk2(v1.x, v1.y); w.w = pk2(v1.z, v1.w);
            *(u32x4*)(T2 + (size_t)row * 256 + 128 + cc) = w; }
        else { u32x4 w; w.x = pk2(sigmoidf_(v0.x), sigmoidf_(v0.y)); w.y = pk2(sigmoidf_(v0.z), sigmoidf_(v0.w)); w.z = pk2(sigmoidf_(v1.x), sigmoidf_(v1.y)); w.w = pk2(sigmoidf_(v1.z), sigmoidf_(v1.w));
            *(u32x4*)(SG + (size_t)row * 256 + cc) = w; } } };
__device__ __forceinline__ int kv_row_of(int row) { return row < NPR ? row : NPR + ((row - NPR) >> 12) * 4608 + 512 + ((row - NPR) & 4095); }
__device__ __forceinline__ void phase_mla_norm(const Ctx& C, int j) {
    unsigned char* ws = C.a->ws; const float* R1 = (const float*)(ws + WS_SCR + S_R1);
    bf16_t* QA = (bf16_t*)(ws + WS_SCR + S_QA); bf16_t* CKV = (bf16_t*)(ws + WS_SCR + S_CKV); bf16_t* KPE = (bf16_t*)(ws + WS_SCR + S_KPE);
    const float* ROPE = (const float*)(ws + WS_ROPE);
    const float* qn = C.a->in[I_QNORM] + j * 384; const float* kvn = C.a->in[I_KVNORM] + j * 256; float* out = C.a->out;
    const int lane = C.lane;
    for (int row = C.gw; row < MROWS + 1024; row += C.NGW) {
        if (row < MROWS) {
            const float* r = R1 + (size_t)row * 768;
            f32x2 q[3]; float s = 0.f;
#pragma unroll
            for (int jj = 0; jj < 3; ++jj) { q[jj] = *(const f32x2*)(r + 2 * lane + 128 * jj); s += q[jj].x * q[jj].x + q[jj].y * q[jj].y; }
            const float rstd = 1.0f / sqrtf(wave_sum(s) * (1.f / 384.f) + 1e-6f);
#pragma unroll
            for (int jj = 0; jj < 3; ++jj) { const int c = 2 * lane + 128 * jj; const f32x2 g = *(const f32x2*)(qn + c);
                *(unsigned*)(QA + (size_t)row * 384 + c) = pk2(q[jj].x * rstd * g.x, q[jj].y * rstd * g.y); }
            const f32x4 kv = *(const f32x4*)(r + 384 + 4 * lane);
            const float rstd2 = 1.0f / sqrtf(wave_sum((kv.x * kv.x + kv.y * kv.y) + (kv.z * kv.z + kv.w * kv.w)) * (1.f / 256.f) + 1e-6f);
            const f32x4 o = kv * rstd2 * *(const f32x4*)(kvn + 4 * lane);
            const int kvrow = kv_row_of(row);
            u32x2 w; w.x = pk2(o.x, o.y); w.y = pk2(o.z, o.w);
            *(u32x2*)(CKV + (size_t)kvrow * 256 + 4 * lane) = w;
            const int b = row >> 8, t = row & 255;
            if (row < NPR) *(f32x4*)(out + OUT_CKV + ((size_t)(b * 2 + j) * 256 + t) * 256 + 4 * lane) = o;
            if (lane < 16) {
                const int p = lane, ax = p >> 3, f = p & 7;
                float x1 = r[640 + 2 * p], x2 = r[640 + 2 * p + 1];
                if (row < NPR) { float* ok = out + OUT_KPE + ((size_t)(b * 2 + j) * 256 + t) * 32 + ax * 16 + f; ok[0] = x1; ok[8] = x2; }
                else { const int tt = (row - NPR) & 4095; const int pos = ax == 0 ? (tt >> 6) : (tt & 63);
                    const float c = ROPE[pos * 8 + f], sn = ROPE[512 + pos * 8 + f]; const float o1 = x1 * c - x2 * sn, o2 = x1 * sn + x2 * c; x1 = o1; x2 = o2; }
                *(unsigned*)(KPE + (size_t)kvrow * 32 + 2 * p) = pk2(x1, x2);
            }
        } else {
            const int idx = row - MROWS, b = idx >> 9, i = idx & 511; const int kvrow = NPR + b * 4608 + i;
            const float* sc = C.a->in[I_CCKV] + ((size_t)(b * 2 + j) * 512 + i) * 256;
            const f32x4 v = *(const f32x4*)(sc + 4 * lane);
            u32x2 w; w.x = pk2(v.x, v.y); w.y = pk2(v.z, v.w);
            *(u32x2*)(CKV + (size_t)kvrow * 256 + 4 * lane) = w;
            if (lane < 16) { const int p = lane, ax = p >> 3, f = p & 7; const float* sk = C.a->in[I_CKPE] + ((size_t)(b * 2 + j) * 512 + i) * 32 + ax * 16 + f;
                *(unsigned*)(KPE + (size_t)kvrow * 32 + 2 * p) = pk2(sk[0], sk[8]); }
        }
    }
}

#define RDL(v, i) __builtin_bit_cast(float, __builtin_amdgcn_readlane(__builtin_bit_cast(int, (v)), (i)))
__device__ __forceinline__ void phase_attn_simple(const Ctx& C) {
    unsigned char* ws = C.a->ws; const bf16_t* Q = (const bf16_t*)(ws + WS_SCR + S_Q); const bf16_t* KV = (const bf16_t*)(ws + WS_SCR + S_KV);
    const bf16_t* KPE = (const bf16_t*)(ws + WS_SCR + S_KPE); bf16_t* O = (bf16_t*)(ws + WS_SCR + S_O); const float* ROPE = (const float*)(ws + WS_ROPE);
    const int lane = C.lane; const float scale = 0.10206207261596577f;
    for (int it = C.gw; it < MROWS * 16; it += C.NGW) {
        const int row = it >> 4, h = it & 15;
        int kbase, ntile;
        if (row < NPR) { kbase = row & ~255; ntile = 4; } else { kbase = NPR + ((row - NPR) >> 12) * 4608; ntile = 72; }
        const bf16_t* qrow = Q + (size_t)row * 1536 + h * 96;
        float qa = bf2f(qrow[lane]); float qb = bf2f(qrow[64 + (lane & 31)]);
        if (row >= NPR) { const int tt = (row - NPR) & 4095; const int p = (lane & 31) >> 1, ax = p >> 3, f = p & 7; const int pos = ax == 0 ? (tt >> 6) : (tt & 63);
            const float c = ROPE[pos * 8 + f], sn = ROPE[512 + pos * 8 + f]; const float other = __shfl_xor(qb, 1);
            qb = (lane & 1) ? (other * sn + qb * c) : (qb * c - other * sn); }
        qa *= scale; qb *= scale;
        float m = -1e30f, l = 0.f, acc = 0.f;
        for (int tile = 0; tile < ntile; ++tile) {
            const int key = kbase + tile * 64 + lane;
            const u32x4* kn = (const u32x4*)(KV + (size_t)key * 2048 + h * 128); const u32x4* kp = (const u32x4*)(KPE + (size_t)key * 32);
            float s = 0.f;
#pragma unroll
            for (int c8 = 0; c8 < 8; ++c8) { const u32x4 w = kn[c8];
                s = fmaf(RDL(qa, 8 * c8 + 0), bflo(w.x), s); s = fmaf(RDL(qa, 8 * c8 + 1), bfhi(w.x), s); s = fmaf(RDL(qa, 8 * c8 + 2), bflo(w.y), s); s = fmaf(RDL(qa, 8 * c8 + 3), bfhi(w.y), s);
                s = fmaf(RDL(qa, 8 * c8 + 4), bflo(w.z), s); s = fmaf(RDL(qa, 8 * c8 + 5), bfhi(w.z), s); s = fmaf(RDL(qa, 8 * c8 + 6), bflo(w.w), s); s = fmaf(RDL(qa, 8 * c8 + 7), bfhi(w.w), s); }
#pragma unroll
            for (int c8 = 0; c8 < 4; ++c8) { const u32x4 w = kp[c8];
                s = fmaf(RDL(qb, 8 * c8 + 0), bflo(w.x), s); s = fmaf(RDL(qb, 8 * c8 + 1), bfhi(w.x), s); s = fmaf(RDL(qb, 8 * c8 + 2), bflo(w.y), s); s = fmaf(RDL(qb, 8 * c8 + 3), bfhi(w.y), s);
                s = fmaf(RDL(qb, 8 * c8 + 4), bflo(w.z), s); s = fmaf(RDL(qb, 8 * c8 + 5), bfhi(w.z), s); s = fmaf(RDL(qb, 8 * c8 + 6), bflo(w.w), s); s = fmaf(RDL(qb, 8 * c8 + 7), bfhi(w.w), s); }
            const float mn = fmaxf(m, wave_max(s)); const float alpha = __expf(m - mn); const float p = __expf(s - mn);
            l = l * alpha + wave_sum(p); acc *= alpha; m = mn;
            const bf16_t* vb = KV + (size_t)(kbase + tile * 64) * 2048 + h * 128 + 64 + lane;
#pragma unroll 16
            for (int jj = 0; jj < 64; ++jj) acc = fmaf(RDL(p, jj), bf2f(vb[(size_t)jj * 2048]), acc);
        }
        O[(size_t)row * 1024 + h * 64 + lane] = (bf16_t)f2bf(acc / l);
    }
}

__device__ __forceinline__ void phase_rw_prep(const Ctx& C, int layer, int part) {
    unsigned char* ws = C.a->ws; const float* X = (const float*)(ws + WS_X); bf16_t* XA = (bf16_t*)(ws + WS_H + R_XA); const float* MOD = (const float*)(ws + WS_MOD);
    const float* mu = C.a->in[I_MU]; const int lane = C.lane;
    const int i0 = part == 0 ? 0 : 1, i1 = part == 0 ? 2 : 4, i2 = part == 0 ? 3 : 5;
    for (int row = C.gw; row < MROWS; row += C.NGW) {
        int t, T; if (row < NPR) { t = row & 255; T = 256; } else { t = (row - NPR) & 4095; T = 4096; }
        const int cd = cond_of_row(row); const float* sh = modp(MOD, layer, cd, 0); const float* sc = modp(MOD, layer, cd, 1);
        const float* xr = X + (size_t)row * DM;
#pragma unroll
        for (int j = 0; j < 4; ++j) { const int c = 4 * lane + 256 * j;
            const f32x4 s1 = *(const f32x4*)(sc + c) + 1.0f, s0 = *(const f32x4*)(sh + c);
            const f32x4 h = *(const f32x4*)(xr + c) * s1 + s0;
            f32x4 hp = (f32x4){0.f, 0.f, 0.f, 0.f}, hn = (f32x4){0.f, 0.f, 0.f, 0.f};
            if (t > 0) hp = *(const f32x4*)(xr - DM + c) * s1 + s0;
            if (t < T - 1) hn = *(const f32x4*)(xr + DM + c) * s1 + s0;
            const f32x4 xx = (hp + hn) * 0.5f - h;
            const f32x4 o0 = h + xx * *(const f32x4*)(mu + i0 * DM + c), o1 = h + xx * *(const f32x4*)(mu + i1 * DM + c), o2 = h + xx * *(const f32x4*)(mu + i2 * DM + c);
            u32x2 w; w.x = pk2(o0.x, o0.y); w.y = pk2(o0.z, o0.w); *(u32x2*)(XA + (size_t)row * DM + c) = w;
            w.x = pk2(o1.x, o1.y); w.y = pk2(o1.z, o1.w); *(u32x2*)(XA + (size_t)MROWS * DM + (size_t)row * DM + c) = w;
            w.x = pk2(o2.x, o2.y); w.y = pk2(o2.z, o2.w); *(u32x2*)(XA + (size_t)2 * MROWS * DM + (size_t)row * DM + c) = w; }
    }
}

__device__ __forceinline__ float dpp_x1(float v) { return __builtin_bit_cast(float, __builtin_amdgcn_mov_dpp(__builtin_bit_cast(int, v), 0xB1, 0xF, 0xF, true)); }
__device__ __forceinline__ float dpp_x2(float v) { return __builtin_bit_cast(float, __builtin_amdgcn_mov_dpp(__builtin_bit_cast(int, v), 0x4E, 0xF, 0xF, true)); }

constexpr int SCAN_BLK = 8;
__device__ __forceinline__ void scan_item(const Ctx& C, int row_first, int T, int h, int dir, int init, const float* initp, bool hasv, bf16_t* yout, float* endp, float* bon) {
    unsigned char* ws = C.a->ws; const float* const* in = C.a->in;
    const bf16_t* Rb = (const bf16_t*)(ws + WS_H + R_R); const bf16_t* Kb = (const bf16_t*)(ws + WS_H + R_K); const bf16_t* Vb = (const bf16_t*)(ws + WS_H + R_V);
    const bf16_t* T2 = (const bf16_t*)(ws + WS_H + R_T2);
    LAS float* opb = (LAS float*)(C.lds + C.wave * 16384);
    const int lane = C.lane, ks = lane & 3, vg = lane >> 2, ch = h * 64 + lane;
    const float w0c = in[I_W0][dir * DM + ch], a0c = in[I_A0][dir * DM + ch], kkc = in[I_KK][ch], kac = in[I_KA][ch], rkc = in[I_RK][ch];
    const float* w2p = in[I_W2] + (size_t)dir * 64 * DM + ch; const float* a2p = in[I_A2] + (size_t)dir * 64 * DM + ch;
    float S[4][16];
#pragma unroll
    for (int i = 0; i < 4; ++i)
#pragma unroll
        for (int j = 0; j < 16; ++j) S[i][j] = (init == 1) ? ((4 * vg + i == 16 * ks + j) ? 1.f : 0.f) : 0.f;
    if (init == 2) {
#pragma unroll
        for (int i = 0; i < 4; ++i)
#pragma unroll
            for (int q = 0; q < 4; ++q) { const f32x4 v = *(const f32x4*)(initp + (4 * vg + i) * 64 + 16 * ks + 4 * q); S[i][4 * q] = v.x; S[i][4 * q + 1] = v.y; S[i][4 * q + 2] = v.z; S[i][4 * q + 3] = v.w; }
    }
    for (int s0 = 0; s0 < T; s0 += SCAN_BLK) {
#pragma unroll 1
        for (int s = 0; s < SCAN_BLK; ++s) {
            const int row = dir == 0 ? row_first + s0 + s : row_first + T - 1 - (s0 + s);
            const float r = bf2f(Rb[(size_t)row * DM + ch]), k = bf2f(Kb[(size_t)row * DM + ch]), v = bf2f(Vb[(size_t)row * DM + ch]);
            const float tw = bf2f(T2[(size_t)row * 256 + dir * 64 + lane]), ta = bf2f(T2[(size_t)row * 256 + 128 + dir * 64 + lane]);
            float wpre = 0.f, apre = 0.f;
#pragma unroll 8
            for (int j = 0; j < 64; ++j) { wpre = fmaf(RDL(tw, j), w2p[(size_t)j * DM], wpre); apre = fmaf(RDL(ta, j), a2p[(size_t)j * DM], apre); }
            const float w = __expf(-0.6065306597126334f * sigmoidf_(w0c + wpre));
            const float a = sigmoidf_(a0c + apre);
            const float kkr = k * kkc; const float nrm = sqrtf(wave_sum(kkr * kkr)); const float kk = kkr / fmaxf(nrm, 1e-12f);
            const float kd = k * (1.0f + (a - 1.0f) * kac);
            const float bsum = wave_sum(r * kd * rkc);
            if (bon && lane == 0) bon[(size_t)row * 16 + h] = bsum;
            LAS float* o = opb + s * 384;
            o[lane] = -kk; o[64 + lane] = w; o[128 + lane] = kk * a; o[192 + lane] = kd; o[256 + lane] = r; o[320 + lane] = hasv ? v : 0.f;
        }
        asm volatile("s_waitcnt lgkmcnt(0)" ::: "memory");
#pragma unroll 1
        for (int s = 0; s < SCAN_BLK; ++s) {
            const int row = dir == 0 ? row_first + s0 + s : row_first + T - 1 - (s0 + s);
            const LAS float* o = opb + s * 384;
            float av[16], wv[16], bv[16], kv[16], rv[16];
#pragma unroll
            for (int q = 0; q < 4; ++q) {
                const f32x4 x0 = *(const LAS f32x4*)(o + 16 * ks + 4 * q), x1 = *(const LAS f32x4*)(o + 64 + 16 * ks + 4 * q), x2 = *(const LAS f32x4*)(o + 128 + 16 * ks + 4 * q),
                            x3 = *(const LAS f32x4*)(o + 192 + 16 * ks + 4 * q), x4 = *(const LAS f32x4*)(o + 256 + 16 * ks + 4 * q);
                av[4 * q] = x0.x; av[4 * q + 1] = x0.y; av[4 * q + 2] = x0.z; av[4 * q + 3] = x0.w;
                wv[4 * q] = x1.x; wv[4 * q + 1] = x1.y; wv[4 * q + 2] = x1.z; wv[4 * q + 3] = x1.w;
                bv[4 * q] = x2.x; bv[4 * q + 1] = x2.y; bv[4 * q + 2] = x2.z; bv[4 * q + 3] = x2.w;
                kv[4 * q] = x3.x; kv[4 * q + 1] = x3.y; kv[4 * q + 2] = x3.z; kv[4 * q + 3] = x3.w;
                rv[4 * q] = x4.x; rv[4 * q + 1] = x4.y; rv[4 * q + 2] = x4.z; rv[4 * q + 3] = x4.w;
            }
            const f32x4 vv4 = *(const LAS f32x4*)(o + 320 + 4 * vg); const float vv[4] = {vv4.x, vv4.y, vv4.z, vv4.w};
            float y[4];
#pragma unroll
            for (int i = 0; i < 4; ++i) {
                float sa = 0.f;
#pragma unroll
                for (int j = 0; j < 16; ++j) sa = fmaf(S[i][j], av[j], sa);
                sa += dpp_x1(sa); sa += dpp_x2(sa);
                float yy = 0.f;
#pragma unroll
                for (int j = 0; j < 16; ++j) { S[i][j] = fmaf(S[i][j], wv[j], fmaf(sa, bv[j], vv[i] * kv[j])); yy = fmaf(S[i][j], rv[j], yy); }
                yy += dpp_x1(yy); yy += dpp_x2(yy); y[i] = yy;
            }
            const float yo = ks == 0 ? y[0] : ks == 1 ? y[1] : ks == 2 ? y[2] : y[3];
            yout[(size_t)row * DM + h * 64 + lane] = (bf16_t)f2bf(yo);
        }
        asm volatile("s_waitcnt lgkmcnt(0)" ::: "memory");
    }
    if (endp) {
#pragma unroll
        for (int i = 0; i < 4; ++i)
#pragma unroll
            for (int q = 0; q < 4; ++q) *(f32x4*)(endp + (4 * vg + i) * 64 + 16 * ks + 4 * q) = (f32x4){S[i][4 * q], S[i][4 * q + 1], S[i][4 * q + 2], S[i][4 * q + 3]};
    }
}
__device__ __forceinline__ void phase_rw_scan_seq(const Ctx& C) {
    unsigned char* ws = C.a->ws; bf16_t* Y = (bf16_t*)(ws + WS_H + R_Y); float* BON = (float*)(ws + WS_H + R_BON);
    for (int it = C.gw; it < 1088; it += C.NGW) {
        if (it < 64) { const int b = it >> 5, h = (it >> 1) & 15, dir = it & 1;
            scan_item(C, NPR + b * 4096, 4096, h, dir, 2, C.a->in[I_SWKV] + ((size_t)(b * 2 + dir) * 16 + h) * 4096, true, Y + (size_t)dir * MROWS * DM, nullptr, BON + (size_t)dir * MROWS * 16);
        } else { const int q = it - 64, b = q >> 5, h = (q >> 1) & 15, dir = q & 1;
            scan_item(C, b * 256, 256, h, dir, 0, nullptr, true, Y + (size_t)dir * MROWS * DM, C.a->out + OUT_WKV + ((size_t)(b * 2 + dir) * 16 + h) * 4096, BON + (size_t)dir * MROWS * 16); }
    }
}
__device__ __forceinline__ void phase_rw_post(const Ctx& C) {
    unsigned char* ws = C.a->ws; bf16_t* Y0 = (bf16_t*)(ws + WS_H + R_Y); const bf16_t* Y1 = Y0 + (size_t)MROWS * DM; const float* BON = (const float*)(ws + WS_H + R_BON);
    const bf16_t* Vb = (const bf16_t*)(ws + WS_H + R_V); const bf16_t* G = (const bf16_t*)(ws + WS_H + R_G);
    const float* lg = C.a->in[I_LNXG]; const float* lb = C.a->in[I_LNXB]; const int lane = C.lane;
    for (int it = C.gw; it < MROWS * 16; it += C.NGW) {
        const int row = it >> 4, h = it & 15, c = h * 64 + lane; const size_t e = (size_t)row * DM + c;
        const float y = bf2f(Y0[e]) + bf2f(Y1[e]);
        const float mean = wave_sum(y) * (1.f / 64.f); const float d = y - mean; const float var = wave_sum(d * d) * (1.f / 64.f);
        const float yn = d * (1.0f / sqrtf(var + 64e-5f)) * lg[c] + lb[c];
        const float bonus = (BON[(size_t)row * 16 + h] + BON[(size_t)MROWS * 16 + (size_t)row * 16 + h]) * bf2f(Vb[e]);
        Y0[e] = (bf16_t)f2bf((yn + bonus) * bf2f(G[e]));
    }
}

__device__ __forceinline__ void phase_pool_prep(const Ctx& C, int layer) {
    unsigned char* ws = C.a->ws; const float* X = (const float*)(ws + WS_X); bf16_t* P = (bf16_t*)(ws + WS_SCR + S_POOL); const float* MOD = (const float*)(ws + WS_MOD);
    const int lane = C.lane;
    for (int row = C.gw; row < MROWS; row += C.NGW) {
        int t, T; if (row < NPR) { t = row & 255; T = 256; } else { t = (row - NPR) & 4095; T = 4096; }
        const float* sc = modp(MOD, layer, cond_of_row(row), 1); const float* xr = X + (size_t)row * DM;
#pragma unroll
        for (int j = 0; j < 4; ++j) { const int c = 4 * lane + 256 * j; const int win = 2 << j;
            int lo = t - win / 2, hi = t - win / 2 + win; lo = lo < 0 ? 0 : lo; hi = hi > T ? T : hi;
            f32x4 s = (f32x4){0.f, 0.f, 0.f, 0.f};
            for (int u = lo; u < hi; ++u) s = s + *(const f32x4*)(xr + (ptrdiff_t)(u - t) * DM + c);
            const f32x4 o = (*(const f32x4*)(sc + c) + 1.0f) * (s * (1.0f / (float)(hi - lo)) - *(const f32x4*)(xr + c));
            u32x2 w; w.x = pk2(o.x, o.y); w.y = pk2(o.z, o.w); *(u32x2*)(P + (size_t)row * DM + c) = w; }
    }
}
namespace pg8 {
#define PG8_LAS __attribute__((address_space(3)))
constexpr int BM = 256, BK = 64, HALF = 128, HTB = HALF * BK * 2, STAGE_BYTES = 8 * HTB, NXCD = 8, WGM = 8;
__host__ __device__ __forceinline__ int lds_byte(int r, int c) { const int st = (r >> 4) * 2 + (c >> 5), rr = r & 15, cc = c & 31, ob = rr * 64 + cc * 2; return st * 1024 + (ob ^ (((ob >> 9) & 1) << 5)); }
__host__ __device__ __forceinline__ void stage_rc(int b, int& R, int& C) { const int st = b / 1024, sb = b % 1024, swz = sb ^ (((sb >> 9) & 1) << 5); R = (st >> 1) * 16 + swz / 64; C = (st & 1) * 32 + (swz % 64) / 2; }
struct Unit { int pm, pn; };
struct Gemm { const bf16_t* Bt; int lda, ldb, K; };
struct StaticOrder {
    int nM, nN, nwg, G, c;
    __host__ __device__ void init(int M, int N, int G_, int c_) { nM = M / BM; nN = N / BM; nwg = nM * nN; G = G_; c = c_; }
    __host__ __device__ bool next(int i, Unit& u) const {
        const long L = (long)i * G + c; if (L >= nwg) return false;
        int wgid = (int)L; { const int q = nwg / NXCD, r = nwg % NXCD, xcd = wgid % NXCD, off = wgid / NXCD; wgid = (xcd < r ? xcd * (q + 1) : r * (q + 1) + (xcd - r) * q) + off; }
        const int nig = WGM * nN, gid = wgid / nig, fm = gid * WGM, gsz = (nM - fm) < WGM ? (nM - fm) : WGM;
        u.pm = fm + ((wgid % nig) % gsz); u.pn = (wgid % nig) / gsz; return true;
    }
    __device__ __forceinline__ void a_ready(const Unit&) const {}
    __device__ __forceinline__ void done(const Unit&) const {}
};
template <class E8> struct EpiWrap {
    static constexpr bool PERM = true, AFTER_DRAIN = false; E8 e;
    __device__ __forceinline__ void operator()(const f32x4 (&acc)[2][2][4][2], const Unit& u, int wr, int wc, int fr, int fq) const {
#pragma unroll
        for (int ai = 0; ai < 2; ++ai)
#pragma unroll
            for (int m = 0; m < 4; ++m) { const int row = u.pm * BM + ai * HALF + wr * 64 + m * 16 + fr;
#pragma unroll
                for (int bj = 0; bj < 2; ++bj) e(row, u.pn * BM + bj * HALF + wc * 32 + 8 * fq, acc[ai][bj][m][0], acc[ai][bj][m][1]); }
    }
};
template <class Epi, class ASel, class Sched, bool ALIGN_EPI = false, bool SP2 = false>
__device__ __forceinline__ void gemm_phase(PG8_LAS unsigned char* lds, const Gemm g, const ASel& asel, const Sched& S, const Epi& E) {
    const int tid = threadIdx.x, wid = __builtin_amdgcn_readfirstlane(tid >> 6), lane = tid & 63, wr = wid >> 2, wc = wid & 3, fr = lane & 15, fq = lane >> 4;
    const int K = g.K, nt = K / BK;
    unsigned voffA[2], voffB[2];
#pragma unroll
    for (int i = 0; i < 2; ++i) { int R, C; stage_rc(tid * 16 + i * 8192, R, C); const int Rb = Epi::PERM ? ((R & ~31) + perm32(R & 31)) : R;
        voffA[i] = (unsigned)(R * g.lda + C) * 2u; voffB[i] = (unsigned)(Rb * g.ldb + C) * 2u; }
    const size_t kstep = (size_t)(BK * 2);
    const size_t hstepA = (size_t)HALF * g.lda * 2, hstepB = (size_t)HALF * g.ldb * 2;
    const size_t tstepA = 2 * hstepA, tstepB = 2 * hstepB;
    const unsigned ldsw = (unsigned)wid * 1024u;
    const int aoff = lds_byte(wr * 64 + fr, fq * 8), boff = lds_byte(wc * 32 + fr, fq * 8);
#define PG8_SA(b, h) (((b) * 2 + (h)) * HTB)
#define PG8_SB(b, h) ((4 + (b) * 2 + (h)) * HTB)
#define PG8_STAGE(bufoff, gbase, voff) do { _Pragma("unroll") for (int _i = 0; _i < 2; ++_i) \
        __builtin_amdgcn_global_load_lds((const unsigned*)((const char*)(gbase) + (voff)[_i]), (PG8_LAS unsigned*)(lds + (bufoff) + ldsw + _i * 8192), 16, 0, 0); } while (0)
#define PG8_LDA(dst, b, h) do { _Pragma("unroll") for (int m = 0; m < 4; ++m) _Pragma("unroll") for (int k = 0; k < 2; ++k) dst[m][k] = *(const PG8_LAS bf16x8*)(lds + PG8_SA(b, h) + aoff + m * 2048 + k * 1024); } while (0)
#define PG8_LDB(dst, b, h) do { _Pragma("unroll") for (int n = 0; n < 2; ++n) _Pragma("unroll") for (int k = 0; k < 2; ++k) dst[n][k] = *(const PG8_LAS bf16x8*)(lds + PG8_SB(b, h) + boff + n * 2048 + k * 1024); } while (0)
#define PG8_MMA(ai, bj, At, Bt) do { __builtin_amdgcn_s_setprio(1); _Pragma("unroll") for (int m = 0; m < 4; ++m) _Pragma("unroll") for (int n = 0; n < 2; ++n) _Pragma("unroll") for (int k = 0; k < 2; ++k) \
        acc[ai][bj][m][n] = __builtin_amdgcn_mfma_f32_16x16x32_bf16(Bt[n][k], At[m][k], acc[ai][bj][m][n], 0, 0, 0); __builtin_amdgcn_s_setprio(0); } while (0)
#define PG8_WAIT_V(n) asm volatile("s_waitcnt vmcnt(" #n ")" ::: "memory")
#define PG8_WAIT_L(n) asm volatile("s_waitcnt lgkmcnt(" #n ")" ::: "memory")
#define PG8_BAR __builtin_amdgcn_s_barrier()
#define PG8_SCHED __builtin_amdgcn_sched_barrier(0)
    Unit cur, nxt; int ui = 0;
    if (!S.next(0, cur)) return;
    f32x4 acc[2][2][4][2];
#pragma unroll
    for (int a = 0; a < 2; ++a)
#pragma unroll
        for (int b = 0; b < 2; ++b)
#pragma unroll
            for (int m = 0; m < 4; ++m)
#pragma unroll
                for (int n = 0; n < 2; ++n) acc[a][b][m][n] = (f32x4){0.f, 0.f, 0.f, 0.f};
    bf16x8 At[4][2], B0[2][2], B1[2][2];
    const char* cA = (const char*)asel(cur.pn * BM) + (size_t)cur.pm * tstepA; const char* cB = (const char*)g.Bt + (size_t)cur.pn * tstepB;
    S.a_ready(cur);
    if constexpr (SP2) {
        PG8_STAGE(PG8_SB(0, 0), cB, voffB); PG8_STAGE(PG8_SB(0, 1), cB + hstepB, voffB); PG8_STAGE(PG8_SA(0, 0), cA, voffA); PG8_STAGE(PG8_SA(0, 1), cA + hstepA, voffA);
        if (wr == 1) PG8_BAR;
        PG8_WAIT_V(2); PG8_BAR;
        PG8_STAGE(PG8_SB(1, 0), cB + kstep, voffB); PG8_STAGE(PG8_SA(1, 0), cA + kstep, voffA); PG8_STAGE(PG8_SB(1, 1), cB + hstepB + kstep, voffB);
        PG8_WAIT_V(6); PG8_BAR;
    } else {
        PG8_STAGE(PG8_SB(0, 0), cB, voffB); PG8_STAGE(PG8_SA(0, 0), cA, voffA); PG8_STAGE(PG8_SB(0, 1), cB + hstepB, voffB); PG8_STAGE(PG8_SA(0, 1), cA + hstepA, voffA);
        if (wr == 1) PG8_BAR;
        PG8_WAIT_V(4); PG8_BAR;
        PG8_STAGE(PG8_SB(1, 0), cB + kstep, voffB); PG8_STAGE(PG8_SA(1, 0), cA + kstep, voffA); PG8_STAGE(PG8_SB(1, 1), cB + hstepB + kstep, voffB);
        PG8_WAIT_V(6); PG8_BAR;
    }
    for (;;) {
        const bool has_next = S.next(ui + 1, nxt);
        const char* nA = has_next ? (const char*)asel(nxt.pn * BM) + (size_t)nxt.pm * tstepA : cA; const char* nB = has_next ? (const char*)g.Bt + (size_t)nxt.pn * tstepB : cB;
        for (int t = 0; t < nt; t += 2) {
            const bool last = (t == nt - 2);
            const char* a1 = cA + (size_t)(t + 1) * kstep;
            const char* a2 = last ? nA : cA + (size_t)(t + 2) * kstep; const char* b2 = last ? nB : cB + (size_t)(t + 2) * kstep;
            const char* a3 = a2 + kstep; const char* b3 = b2 + kstep;
            if (last && has_next) S.a_ready(nxt);
            if constexpr (SP2) {
            PG8_LDB(B0, 0, 0); PG8_LDB(B1, 0, 1); PG8_SCHED; PG8_LDA(At, 0, 0); PG8_STAGE(PG8_SA(1, 1), a1 + hstepA, voffA);
            PG8_WAIT_V(8); PG8_WAIT_L(0); PG8_BAR; PG8_MMA(0, 0, At, B0); PG8_MMA(0, 1, At, B1); PG8_BAR; PG8_SCHED;
            PG8_LDA(At, 0, 1); PG8_STAGE(PG8_SB(0, 0), b2, voffB); PG8_STAGE(PG8_SB(0, 1), b2 + hstepB, voffB); PG8_STAGE(PG8_SA(0, 0), a2, voffA);
            PG8_WAIT_V(8); PG8_WAIT_L(0); PG8_BAR; PG8_MMA(1, 0, At, B0); PG8_MMA(1, 1, At, B1); PG8_BAR; PG8_SCHED;
            PG8_LDB(B0, 1, 0); PG8_LDB(B1, 1, 1); PG8_SCHED; PG8_LDA(At, 1, 0); PG8_STAGE(PG8_SA(0, 1), a2 + hstepA, voffA);
            PG8_WAIT_V(8); PG8_WAIT_L(0); PG8_BAR; PG8_MMA(0, 0, At, B0); PG8_MMA(0, 1, At, B1); PG8_BAR; PG8_SCHED;
            PG8_LDA(At, 1, 1); PG8_STAGE(PG8_SB(1, 0), b3, voffB); PG8_STAGE(PG8_SB(1, 1), b3 + hstepB, voffB); PG8_STAGE(PG8_SA(1, 0), a3, voffA);
            PG8_WAIT_V(8); PG8_WAIT_L(0); PG8_BAR; PG8_MMA(1, 0, At, B0); PG8_MMA(1, 1, At, B1); PG8_BAR; PG8_SCHED;
            } else {
            PG8_LDB(B0, 0, 0); PG8_SCHED; PG8_LDA(At, 0, 0); PG8_STAGE(PG8_SA(1, 1), a1 + hstepA, voffA);
            PG8_WAIT_L(8); PG8_BAR; PG8_WAIT_L(0); PG8_MMA(0, 0, At, B0); PG8_BAR; PG8_SCHED;
            PG8_LDB(B1, 0, 1); PG8_STAGE(PG8_SB(0, 0), b2, voffB);
            PG8_BAR; PG8_WAIT_L(0); PG8_MMA(0, 1, At, B1); PG8_BAR;
            PG8_LDA(At, 0, 1); PG8_STAGE(PG8_SA(0, 0), a2, voffA);
            PG8_BAR; PG8_WAIT_L(0); PG8_MMA(1, 0, At, B0); PG8_BAR; PG8_SCHED;
            PG8_STAGE(PG8_SB(0, 1), b2 + hstepB, voffB);
            PG8_WAIT_V(6); PG8_BAR; PG8_MMA(1, 1, At, B1); PG8_BAR;
            PG8_LDB(B0, 1, 0); PG8_SCHED; PG8_LDA(At, 1, 0); PG8_STAGE(PG8_SA(0, 1), a2 + hstepA, voffA);
            PG8_WAIT_L(8); PG8_BAR; PG8_WAIT_L(0); PG8_MMA(0, 0, At, B0); PG8_BAR; PG8_SCHED;
            PG8_LDB(B1, 1, 1); PG8_STAGE(PG8_SB(1, 0), b3, voffB);
            PG8_BAR; PG8_WAIT_L(0); PG8_MMA(0, 1, At, B1); PG8_BAR;
            PG8_LDA(At, 1, 1); PG8_STAGE(PG8_SA(1, 0), a3, voffA);
            PG8_BAR; PG8_WAIT_L(0); PG8_MMA(1, 0, At, B0); PG8_BAR; PG8_SCHED;
            PG8_STAGE(PG8_SB(1, 1), b3 + hstepB, voffB);
            PG8_WAIT_V(6); PG8_BAR; PG8_MMA(1, 1, At, B1); PG8_BAR;
            }
        }
        if constexpr (ALIGN_EPI) { if (wr == 0) PG8_BAR; }
        if constexpr (!Epi::AFTER_DRAIN) { E(acc, cur, wr, wc, fr, fq); S.done(cur); }
        if (!has_next) break;
#pragma unroll
        for (int a = 0; a < 2; ++a)
#pragma unroll
            for (int b = 0; b < 2; ++b)
#pragma unroll
                for (int m = 0; m < 4; ++m)
#pragma unroll
                    for (int n = 0; n < 2; ++n) acc[a][b][m][n] = (f32x4){0.f, 0.f, 0.f, 0.f};
        cur = nxt; cA = nA; cB = nB; ++ui;
        if constexpr (ALIGN_EPI) { if (wr == 1) PG8_BAR; }
    }
    PG8_WAIT_V(0);
    if constexpr (!ALIGN_EPI) { if (wr == 0) PG8_BAR; }
    PG8_BAR;
    if constexpr (Epi::AFTER_DRAIN) { E.fused(acc, cur, wr, wc, fr, fq, lds, wid, lane); S.done(cur); }
#undef PG8_SA
#undef PG8_SB
#undef PG8_STAGE
#undef PG8_LDA
#undef PG8_LDB
#undef PG8_MMA
#undef PG8_WAIT_V
#undef PG8_WAIT_L
#undef PG8_BAR
#undef PG8_SCHED
}
}
template <class ASel, class Epi>
__device__ __forceinline__ void gemm_fast(const Ctx& C, const ASel& asel, int lda, const bf16_t* Bt, int ldb, int Mr, int N, int K, const Epi& epi) {
    pg8::Gemm g{Bt, lda, ldb, K}; pg8::StaticOrder S; S.init(Mr, N, (int)gridDim.x, (int)blockIdx.x);
    pg8::EpiWrap<Epi> E{epi};
    pg8::gemm_phase<pg8::EpiWrap<Epi>, ASel, pg8::StaticOrder, true, true>(C.lds, g, asel, S, E);
}
#ifndef MK_MULTI
#define MK_MULTI 0
#endif
constexpr int NPHASES = 38;

__global__ void __launch_bounds__(NWAVES * 64, 2) mega_fwd(Args args) {
    extern __shared__ __attribute__((aligned(16))) unsigned char lds_raw[];
    Ctx C; C.a = &args; C.lds = (LAS unsigned char*)lds_raw;
    C.tid = threadIdx.x; C.lane = C.tid & 63; C.wave = __builtin_amdgcn_readfirstlane(C.tid >> 6);
    C.gw = blockIdx.x * NWAVES + C.wave; C.NGW = gridDim.x * NWAVES;
    volatile LAS unsigned* MISC = (volatile LAS unsigned*)(C.lds + MISC_OFF);
    if (C.tid < 32) MISC[C.tid] = 0u;
    __syncthreads();
    unsigned char* ws = args.ws;
    unsigned* ctl = (unsigned*)(ws + WS_CTL);
    XcdBarrier bar; bar.bar = ctl + CW_BAR; bar.x = 0; bar.st = MISC + 8;
    if (!MK_MULTI) bar = xcd_barrier_post(ctl + CW_BAR, MISC + 8);
    const int lo = args.ph_lo, hi = args.ph_hi; int ph = 0;
#define PHASE(body) do { if (ph >= lo && ph < hi) { body; if (!MK_MULTI && ph + 1 < hi) xcd_barrier(bar); else __syncthreads(); } ++ph; } while (0)

    bf16_t* WB = (bf16_t*)(ws + WS_W); float* X = (float*)(ws + WS_X); const bf16_t* H = (const bf16_t*)(ws + WS_H); const float* MOD = (const float*)(ws + WS_MOD);
    PHASE(phase0(C));
    PHASE(phase_init(C));
#define DO_LAYER(layer) do { \
        const int kind = layer % 3, j = layer / 3; \
        if (kind == 0) { \
            unsigned char* wm = (unsigned char*)WB + W_MLA + j * W_MLA_STRIDE; \
            PHASE(gemm_fast(C, ASelPlain{H}, 1024, (const bf16_t*)(wm + W_MLA_1), 1024, MROWS, 768, 1024, EpiF32{(float*)(ws + WS_SCR + S_R1), 768})); \
            PHASE(phase_mla_norm(C, j)); \
            PHASE(gemm_fast(C, ASelPlain{(const bf16_t*)(ws + WS_SCR + S_QA)}, 384, (const bf16_t*)(wm + W_MLA_QB), 384, MROWS, 1536, 384, EpiBf16{(bf16_t*)(ws + WS_SCR + S_Q), 1536}); \
                  gemm_fast(C, ASelPlain{(const bf16_t*)(ws + WS_SCR + S_CKV)}, 256, (const bf16_t*)(wm + W_MLA_KVB), 256, KVR, 2048, 256, EpiBf16{(bf16_t*)(ws + WS_SCR + S_KV), 2048})); \
            PHASE(phase_attn_simple(C)); \
            PHASE(gemm_fast(C, ASelPlain{(const bf16_t*)(ws + WS_SCR + S_O)}, 1024, (const bf16_t*)(wm + W_MLA_O), 1024, MROWS, 1024, 1024, EpiResid{X, MOD, layer, 2, nullptr})); \
        } else if (kind == 1) { \
            unsigned char* wr = (unsigned char*)WB + W_RW; const bf16_t* XA = (const bf16_t*)(ws + WS_H + R_XA); \
            PHASE(phase_rw_prep(C, layer, 0)); \
            PHASE(gemm_fast(C, ASelShift{XA, 10, (size_t)MROWS * DM}, 1024, (const bf16_t*)(wr + W_RW_1), 1024, MROWS, 3072, 1024, EpiRwA{(bf16_t*)(ws + WS_H + R_R)})); \
            PHASE(phase_rw_prep(C, layer, 1)); \
            PHASE(gemm_fast(C, ASelShift{XA, 8, (size_t)MROWS * DM}, 1024, (const bf16_t*)(wr + W_RW_1) + (size_t)3072 * 1024, 1024, MROWS, 768, 1024, EpiRwB{(bf16_t*)(ws + WS_H + R_T2), (bf16_t*)(ws + WS_H + R_SG)})); \
            PHASE(phase_rw_scan_seq(C)); \
            PHASE(gemm_fast(C, ASelPlain{(const bf16_t*)(ws + WS_H + R_SG)}, 256, (const bf16_t*)(wr + W_RW_G2T), 256, MROWS, 1024, 256, EpiBf16{(bf16_t*)(ws + WS_H + R_G), 1024})); \
            PHASE(phase_rw_post(C)); \
            PHASE(gemm_fast(C, ASelPlain{(const bf16_t*)(ws + WS_H + R_Y)}, 1024, (const bf16_t*)(wr + W_RW_O), 1024, MROWS, 1024, 1024, EpiResid{X, MOD, layer, 2, nullptr})); \
        } else { \
            PHASE(phase_pool_prep(C, layer)); \
            PHASE(gemm_fast(C, ASelShift{(const bf16_t*)(ws + WS_SCR + S_POOL), 8, (size_t)256}, 1024, (const bf16_t*)((unsigned char*)WB + W_POOL), 256, MROWS, 1024, 256, EpiResid{X, MOD, layer, 2, args.in[I_POOLS]})); \
        } \
        PHASE(phase_ln(C, layer, 0, layer, 3, false)); \
        PHASE(gemm_fast(C, ASelPlain{H}, 1024, (const bf16_t*)((unsigned char*)WB + layer * W_FFN_STRIDE + W_FFN_GU), 1024, MROWS, 5632, 1024, EpiSwiglu{(bf16_t*)(ws + WS_SCR + S_ACT)})); \
        PHASE(gemm_fast(C, ASelPlain{(const bf16_t*)(ws + WS_SCR + S_ACT)}, 2816, (const bf16_t*)((unsigned char*)WB + layer * W_FFN_STRIDE + W_FFN_D), 2816, MROWS, 1024, 2816, EpiResid{X, MOD, layer, 5, nullptr})); \
        PHASE(phase_ln(C, layer, 1, layer + 1, (layer == 2) ? 0 : -1, layer == 3)); \
     \
} while (0)
    DO_LAYER(0); DO_LAYER(1); DO_LAYER(2); DO_LAYER(3);
    if (!MK_MULTI && xb_ld(ctl + CW_BAR + XB_TMO) != 0u && blockIdx.x == 0 && C.tid == 0) args.out[0] = __builtin_nanf("");
}

extern "C" void kernel_launch(void* const* d_in, const int* in_sizes, int n_in, void* d_out, int out_size, void* d_ws, size_t ws_size, hipStream_t stream) {
    static int grid = 0;
    if (grid == 0) {
        int dev = 0, cus = 0, per_cu = 0;
        if (hipGetDevice(&dev) != hipSuccess || hipDeviceGetAttribute(&cus, hipDeviceAttributeMultiprocessorCount, dev) != hipSuccess) grid = -1;
        else if (hipFuncSetAttribute((const void*)mega_fwd, hipFuncAttributeMaxDynamicSharedMemorySize, LDS_BYTES) != hipSuccess) grid = -1;
        else {
            if (hipOccupancyMaxActiveBlocksPerMultiprocessor(&per_cu, (const void*)mega_fwd, NWAVES * 64, LDS_BYTES) != hipSuccess || per_cu < 1) { fprintf(stderr, "occupancy query: %d\n", per_cu); grid = -1; }
            else grid = cus;
            (void)hipGetLastError();
        }
        if (n_in != 41 || out_size != OUT_TOTAL || ws_size < WS_END) { fprintf(stderr, "kernel_launch: unexpected n_in %d out %d ws %zu\n", n_in, out_size, ws_size); grid = -2; }
    }
    if (grid == -2) { (void)hipMemsetAsync(d_out, 0xFF, (size_t)out_size * 4, stream); return; }
    if (grid < 0) return;
    (void)hipMemsetAsync((char*)d_ws + WS_CTL, 0, CTL_ZERO_BYTES, stream);
    Args a{};
    for (int i = 0; i < 41; ++i) a.in[i] = (const float*)d_in[i];
    a.out = (float*)d_out; a.ws = (unsigned char*)d_ws;
#if MK_MULTI
    for (int p = 0; p < NPHASES; ++p) { a.ph_lo = p; a.ph_hi = p + 1; hipLaunchKernelGGL(mega_fwd, dim3(grid), dim3(NWAVES * 64), LDS_BYTES, stream, a); }
#else
    a.ph_lo = 0; a.ph_hi = NPHASES;
    void* kargs[] = {&a};
    hipError_t e = hipLaunchCooperativeKernel((const void*)mega_fwd, dim3(grid), dim3(NWAVES * 64), kargs, LDS_BYTES, stream);
    if (e != hipSuccess) fprintf(stderr, "cooperative launch failed: %s (grid %d)\n", hipGetErrorString(e), grid);
#endif
}
```

```cpp
#include <hip/hip_runtime.h>
#include <cstdio>
#include <cstdint>

#define GAS __attribute__((address_space(1)))
#define LAS __attribute__((address_space(3)))
typedef unsigned short bf16_t;
typedef float f32x4 __attribute__((ext_vector_type(4)));
typedef float f32x2 __attribute__((ext_vector_type(2)));
typedef unsigned u32x4 __attribute__((ext_vector_type(4)));
typedef unsigned u32x2 __attribute__((ext_vector_type(2)));
typedef short bf16x8 __attribute__((ext_vector_type(8)));

constexpr int DM = 1024, NPR = 8192, MROWS = 16384, DFF = 2816, NHEAD = 16;
constexpr int KVR = 17408;
constexpr float ALPHA = 1.681792830507429f;
constexpr int OUT_YP = 0, OUT_YS = 8388608, OUT_CKV = 16777216, OUT_KPE = 20971520, OUT_WKV = 21495808, OUT_TOTAL = 25690112;

constexpr size_t MiB = 1u << 20;
constexpr size_t WS_CTL = 0, CTL_ZERO_BYTES = 1 * MiB;
constexpr size_t WS_MOD = 1 * MiB;
constexpr size_t WS_ROPE = WS_MOD + 512 * 1024;
constexpr size_t WS_BON = WS_MOD + 576 * 1024;
constexpr size_t WS_W = 2 * MiB;
constexpr size_t W_FFN_GU = 0, W_FFN_D = 11 * MiB, W_FFN_STRIDE = 16 * MiB + 512 * 1024;
constexpr size_t W_MLA = 66 * MiB, W_MLA_STRIDE = 6 * MiB;
constexpr size_t W_MLA_1 = 0, W_MLA_QB = 1536 * 1024, W_MLA_KVB = 1536 * 1024 + 1152 * 1024, W_MLA_O = 1536 * 1024 + 1152 * 1024 + 1024 * 1024;
constexpr size_t W_RW = 78 * MiB;
constexpr size_t W_RW_1 = 0, W_RW_G2T = 7 * MiB + 512 * 1024, W_RW_O = 8 * MiB, W_RW_W2T = 10 * MiB, W_RW_A2T = 10 * MiB + 256 * 1024;
constexpr size_t W_POOL = 91 * MiB;
constexpr size_t WS_X = 94 * MiB;
constexpr size_t WS_H = 158 * MiB;
constexpr size_t WS_SCR = 190 * MiB;
constexpr size_t WS_END = 384 * MiB;
constexpr size_t S_R1 = 0, S_Q = 0, S_KV = 48 * MiB, S_O = 116 * MiB, S_QA = 148 * MiB, S_CKV = 160 * MiB, S_KPE = 169 * MiB;
constexpr size_t S_ACT = 0;
constexpr size_t S_POOL = 0;
constexpr size_t R_XA = 0, R_R = 96 * MiB, R_K = 128 * MiB, R_V = 160 * MiB, R_T2 = 192 * MiB, R_SG = 200 * MiB, R_Y = 0, R_QT = 64 * MiB, R_EP = 208 * MiB, R_BON = 224 * MiB, R_G = 96 * MiB, R_SS = 128 * MiB;

constexpr int NWAVES = 8;
constexpr int LDS_BYTES = 147456;
constexpr int MISC_OFF = LDS_BYTES - 128;
constexpr int CW_BAR = 4096;

__device__ __forceinline__ unsigned f2bf(float f) { unsigned u = __builtin_bit_cast(unsigned, f); return (u + 0x7fffu + ((u >> 16) & 1u)) >> 16; }
typedef __bf16 bf16x2_t __attribute__((ext_vector_type(2)));
__device__ __forceinline__ unsigned pk2(float lo, float hi) { const f32x2 v = {lo, hi}; const bf16x2_t b = __builtin_convertvector(v, bf16x2_t); return __builtin_bit_cast(unsigned, b); }
__device__ __forceinline__ float bf2f(unsigned short b) { return __builtin_bit_cast(float, (unsigned)b << 16); }
__device__ __forceinline__ float bflo(unsigned w) { return __builtin_bit_cast(float, w << 16); }
__device__ __forceinline__ float bfhi(unsigned w) { return __builtin_bit_cast(float, w & 0xffff0000u); }
__device__ __forceinline__ float wave_sum(float v) {
#pragma unroll
    for (int o = 1; o < 64; o <<= 1) v += __shfl_xor(v, o);
    return v;
}
__device__ __forceinline__ float wave_max(float v) {
#pragma unroll
    for (int o = 1; o < 64; o <<= 1) v = fmaxf(v, __shfl_xor(v, o));
    return v;
}
__device__ __forceinline__ float sigmoidf_(float x) { return 1.0f / (1.0f + __expf(-x)); }
__device__ __forceinline__ float siluf_(float x) { return x / (1.0f + __expf(-x)); }
__device__ __forceinline__ int cond_of_row(int row) { return row < NPR ? 0 : 1 + ((row - NPR) >> 12); }
__device__ __forceinline__ const float* modp(const float* MOD, int layer, int cond, int j) { return MOD + (size_t)((layer * 3 + cond) * 6 + j) * DM; }
__device__ __forceinline__ int perm32(int rho) { const int n = rho >> 4, i = rho & 15; return 8 * (i >> 2) + 4 * n + (i & 3); }

#define XB_TMO      128
#define XB_XCNT(j)  (256  + 64 * (j))
#define XB_XSUB(j)  (1280 + 64 * (j))
#define XB_XGEN(j)  (2304 + 64 * (j))
#define XB_TOP      3328
#define XB_TOPGEN   3392
#define XCD_BAR_WORDS 3456
#define XB_SPIN_CAP (1u << 18)
__device__ __forceinline__ unsigned xb_ld(unsigned* p)              { return __hip_atomic_load(p, __ATOMIC_RELAXED, __HIP_MEMORY_SCOPE_AGENT); }
__device__ __forceinline__ unsigned xb_add(unsigned* p, unsigned v) { return __hip_atomic_fetch_add(p, v, __ATOMIC_RELAXED, __HIP_MEMORY_SCOPE_AGENT); }
__device__ __forceinline__ unsigned xb_xcc_id() { return (unsigned)__builtin_amdgcn_s_getreg((3 << 11) | 20) & 0xFu; }
#define XB_SPIN(cond, bar) do { unsigned _sp = 0; while (cond) { __builtin_amdgcn_s_sleep(1); \
    if ((++_sp & 255u) == 0u) { if (xb_ld(&(bar)[XB_TMO])) break; if (_sp > XB_SPIN_CAP) { atomicAdd(&(bar)[XB_TMO], 1u); break; } } } } while (0)
struct XcdBarrier { unsigned* bar; unsigned x; volatile LAS unsigned* st; };
__device__ __forceinline__ XcdBarrier xcd_barrier_post(unsigned* bar, volatile LAS unsigned* st) {
    XcdBarrier b; b.bar = bar; b.x = xb_xcc_id(); b.st = st;
    if (threadIdx.x == 0) (void)xb_add(&bar[XB_XCNT(b.x)], 1u);
    return b;
}
__device__ __forceinline__ void xcd_barrier_complete(unsigned* bar, unsigned x, unsigned& nloc, unsigned& nx) {
    const unsigned G = gridDim.x * gridDim.y * gridDim.z;
    unsigned sum, cnt, mine, sp = 0u;
    for (;;) {
        sum = 0u; cnt = 0u; mine = 0u;
#pragma unroll
        for (unsigned j = 0; j < 16; ++j) { const unsigned c = xb_ld(&bar[XB_XCNT(j)]); sum += c; cnt += (c > 0u) ? 1u : 0u; mine = (j == x) ? c : mine; }
        if (sum == G) break;
        __builtin_amdgcn_s_sleep(1);
        if ((++sp & 255u) == 0u) { if (xb_ld(&bar[XB_TMO])) break; if (sp > XB_SPIN_CAP) { atomicAdd(&bar[XB_TMO], 1u); break; } }
    }
    nloc = mine > 0u ? mine : 1u; nx = cnt > 0u ? cnt : 1u;
}
__device__ __forceinline__ void xcd_barrier(const XcdBarrier& b) {
    asm volatile("s_waitcnt vmcnt(0)" ::: "memory");
    __syncthreads();
    if (threadIdx.x == 0) {
        unsigned* bar = b.bar;
        __builtin_amdgcn_s_waitcnt(0);
        unsigned nloc = b.st[0], nx = b.st[1];
        if (nloc == 0u) { xcd_barrier_complete(bar, b.x, nloc, nx); b.st[0] = nloc; b.st[1] = nx; }
        const unsigned old = xb_add(&bar[XB_XSUB(b.x)], 1u);
        const unsigned gen = old / nloc;
        if (old + 1u == (gen + 1u) * nloc) {
            __builtin_amdgcn_fence(__ATOMIC_RELEASE, "agent");
            asm volatile("s_waitcnt vmcnt(0)" ::: "memory");
            const unsigned og = xb_add(&bar[XB_TOP], 1u);
            const unsigned tg = og / nx;
            if (og + 1u == (tg + 1u) * nx) xb_add(&bar[XB_TOPGEN], 1u);
            else XB_SPIN(xb_ld(&bar[XB_TOPGEN]) == tg, bar);
            __builtin_amdgcn_fence(__ATOMIC_ACQUIRE, "agent");
            xb_add(&bar[XB_XGEN(b.x)], 1u);
            asm volatile("s_waitcnt vmcnt(0)" ::: "memory");
        } else {
            XB_SPIN(xb_ld(&bar[XB_XGEN(b.x)]) == gen, bar);
            __builtin_amdgcn_fence(__ATOMIC_ACQUIRE, "agent");
            asm volatile("s_waitcnt vmcnt(0)" ::: "memory");
        }
    }
    __syncthreads();
}
struct Args { const float* in[41]; float* out; unsigned char* ws; int ph_lo, ph_hi; };
enum { I_XP = 0, I_XS, I_CCKV, I_CKPE, I_SWKV, I_C, I_CCTX, I_ADAW, I_ADAB, I_LNG, I_LNB, I_WG, I_WU, I_WD, I_WQA, I_QNORM, I_WQB, I_WKVA, I_KVNORM, I_WKVB, I_MWO,
       I_MU, I_WR, I_WK, I_WV, I_W0, I_W1, I_W2, I_A0, I_A1, I_A2, I_G1, I_G2, I_KK, I_KA, I_RK, I_LNXG, I_LNXB, I_RWO, I_POOLW, I_POOLS };

struct Ctx {
    const Args* a;
    LAS unsigned char* lds;
    int tid, lane, wave, gw, NGW;
};

enum { MAP_ID = 0, MAP_GU = 1, MAP_QB = 2, MAP_KVA = 3 };
__device__ __forceinline__ int map_row(int map, int mp, int n) {
    if (map == MAP_ID) return mp + n;
    if (map == MAP_GU) return (n >> 2) * 8 + mp * 4 + (n & 3);
    if (map == MAP_QB) { const int h = n / 96, d = n - h * 96; if (d < 64) return n; const int i = d - 64; return h * 96 + 64 + (i & 16) + ((i & 7) << 1) + ((i >> 3) & 1); }
           { if (n < 256) return 384 + n; const int i = n - 256; return 640 + (i & 16) + ((i & 7) << 1) + ((i >> 3) & 1); }
}
__device__ __forceinline__ void conv_tile(const float* W, int ldw, int nblk, int tile, bf16_t* WT, int ldk, int koff, int map, int mp, LAS float* scr, int lane) {
    const int kb = tile / nblk, nb = tile - kb * nblk, k0 = 64 * kb, n0 = 32 * nb;
#pragma unroll 8
    for (int i = 0; i < 32; ++i) { const int kk = 2 * i + (lane >> 5); scr[kk * 33 + (lane & 31)] = W[(size_t)(k0 + kk) * ldw + n0 + (lane & 31)]; }
    asm volatile("s_waitcnt lgkmcnt(0)" ::: "memory");
    const int c = lane & 7;
#pragma unroll
    for (int j = 0; j < 4; ++j) { const int n = (lane >> 3) + 8 * j; const LAS float* s = scr + (8 * c) * 33 + n;
        u32x4 o; o.x = pk2(s[0 * 33], s[1 * 33]); o.y = pk2(s[2 * 33], s[3 * 33]); o.z = pk2(s[4 * 33], s[5 * 33]); o.w = pk2(s[6 * 33], s[7 * 33]);
        *(u32x4*)(WT + (size_t)map_row(map, mp, n0 + n) * ldk + koff + k0 + 8 * c) = o; }
    asm volatile("s_waitcnt lgkmcnt(0)" ::: "memory");
}
__device__ __forceinline__ void zero_rect_item(bf16_t* Wt, int ld, int r0, int c0, int nc, int item, int lane) {
    const int cpr = nc >> 3; const int idx = item * 64 + lane; const int r = idx / cpr, c = idx - r * cpr;
    *(u32x4*)(Wt + (size_t)(r0 + r) * ld + c0 + 8 * c) = (u32x4){0u, 0u, 0u, 0u};
}
__device__ __forceinline__ void adaln_item(const Ctx& C, int item, float* MOD) {
    const int layer = item / 96, cg = item - layer * 96, col = cg * 64 + C.lane;
    const float* W = C.a->in[I_ADAW] + (size_t)layer * DM * 6144 + col;
    const float* cx = C.a->in[I_CCTX]; const float* c0 = C.a->in[I_C]; const float* c1 = c0 + DM;
    float a0 = 0.f, a1 = 0.f, a2 = 0.f;
    for (int kb = 0; kb < DM; kb += 64) {
        const float s0 = siluf_(cx[kb + C.lane]), s1 = siluf_(c0[kb + C.lane]), s2 = siluf_(c1[kb + C.lane]);
#pragma unroll
        for (int kk = 0; kk < 64; ++kk) {
            const float w = W[(size_t)(kb + kk) * 6144];
            a0 = fmaf(__builtin_bit_cast(float, __builtin_amdgcn_readlane(__builtin_bit_cast(int, s0), kk)), w, a0);
            a1 = fmaf(__builtin_bit_cast(float, __builtin_amdgcn_readlane(__builtin_bit_cast(int, s1), kk)), w, a1);
            a2 = fmaf(__builtin_bit_cast(float, __builtin_amdgcn_readlane(__builtin_bit_cast(int, s2), kk)), w, a2);
        }
    }
    const float b = C.a->in[I_ADAB][layer * 6144 + col];
    MOD[(size_t)(layer * 3 + 0) * 6144 + col] = a0 + b;
    MOD[(size_t)(layer * 3 + 1) * 6144 + col] = a1 + b;
    MOD[(size_t)(layer * 3 + 2) * 6144 + col] = a2 + b;
}
__device__ __forceinline__ void rope_tables(float* ROPE, int t) {
    if (t >= 8) return;
    const double invf[8] = {1.0, 0.31622776601683794, 0.1, 0.031622776601683794, 0.01, 0.0031622776601683794, 0.001, 0.00031622776601683794};
    double th = 1.0;
#pragma unroll
    for (int f = 0; f < 8; ++f) th = (t == f) ? invf[f] : th;
    double s = 0.0, c = 0.0, term = 1.0;
#pragma unroll
    for (int n = 0; n < 22; ++n) { if ((n & 1) == 0) c += ((n & 2) ? -term : term); else s += ((n & 2) ? -term : term); term = term * th / (double)(n + 1); }
    double cr = 1.0, sr = 0.0;
    for (int p = 0; p < 64; ++p) { ROPE[p * 8 + t] = (float)cr; ROPE[512 + p * 8 + t] = (float)sr; const double c2 = cr * c - sr * s, s2 = sr * c + cr * s; cr = c2; sr = s2; }
}

#define JOB(n, call) { const int _n = (n); if (r < _n) { call; continue; } r -= _n; }
__device__ __forceinline__ void phase0(const Ctx& C) {
    unsigned char* ws = C.a->ws; bf16_t* WB = (bf16_t*)(ws + WS_W);
    LAS float* scr = (LAS float*)(C.lds + C.wave * 16384);
    float* MOD = (float*)(ws + WS_MOD);
    if (C.gw == 0) rope_tables((float*)(ws + WS_ROPE), C.lane);
    const float* const* in = C.a->in;
    constexpr int T_GU = (1024 / 64) * (2816 / 32), T_D = (2816 / 64) * (1024 / 32);
    constexpr int T_QA = 16 * 12, T_KVA = 16 * 9, T_QB = 6 * 48, T_KVB = 4 * 64, T_SQ = 16 * 32, T_W1 = 16 * 2, T_G1 = 16 * 4, T_G2 = 2 * 32, T_PW = 4 * 8, T_W2 = 1 * 32;
    constexpr int N_ADA = 4 * 96;
    constexpr int TOTAL = N_ADA + 4 * (2 * T_GU + T_D) + 2 * (T_QA + T_KVA + T_QB + T_KVB + T_SQ) + 3 * T_SQ + 4 * T_W1 + T_G1 + T_G2 + T_SQ + 4 * T_PW + 4 * T_W2
                        + 2 * (96 * 1024 / 8 / 64) + 3 * (128 * 1024 / 8 / 64) + (1024 * 128 / 8 / 64);
    for (int it = C.gw; it < TOTAL; it += C.NGW) {
        int r = it;
        JOB(N_ADA, adaln_item(C, r, MOD));
        bool done = false;
#pragma unroll 1
        for (int L = 0; L < 4 && !done; ++L) {
            bf16_t* gu = (bf16_t*)((unsigned char*)WB + L * W_FFN_STRIDE + W_FFN_GU); bf16_t* wd = (bf16_t*)((unsigned char*)WB + L * W_FFN_STRIDE + W_FFN_D);
            if (r < T_GU) { conv_tile(in[I_WG] + (size_t)L * 1024 * 2816, 2816, 88, r, gu, 1024, 0, MAP_GU, 0, scr, C.lane); done = true; break; } r -= T_GU;
            if (r < T_GU) { conv_tile(in[I_WU] + (size_t)L * 1024 * 2816, 2816, 88, r, gu, 1024, 0, MAP_GU, 1, scr, C.lane); done = true; break; } r -= T_GU;
            if (r < T_D)  { conv_tile(in[I_WD] + (size_t)L * 2816 * 1024, 1024, 32, r, wd, 2816, 0, MAP_ID, 0, scr, C.lane); done = true; break; } r -= T_D;
        }
        if (done) continue;
#pragma unroll 1
        for (int j = 0; j < 2 && !done; ++j) {
            unsigned char* wm = (unsigned char*)WB + W_MLA + j * W_MLA_STRIDE;
            if (r < T_QA)  { conv_tile(in[I_WQA] + (size_t)j * 1024 * 384, 384, 12, r, (bf16_t*)(wm + W_MLA_1), 1024, 0, MAP_ID, 0, scr, C.lane); done = true; break; } r -= T_QA;
            if (r < T_KVA) { conv_tile(in[I_WKVA] + (size_t)j * 1024 * 288, 288, 9, r, (bf16_t*)(wm + W_MLA_1), 1024, 0, MAP_KVA, 0, scr, C.lane); done = true; break; } r -= T_KVA;
            if (r < T_QB)  { conv_tile(in[I_WQB] + (size_t)j * 384 * 1536, 1536, 48, r, (bf16_t*)(wm + W_MLA_QB), 384, 0, MAP_QB, 0, scr, C.lane); done = true; break; } r -= T_QB;
            if (r < T_KVB) { conv_tile(in[I_WKVB] + (size_t)j * 256 * 2048, 2048, 64, r, (bf16_t*)(wm + W_MLA_KVB), 256, 0, MAP_ID, 0, scr, C.lane); done = true; break; } r -= T_KVB;
            if (r < T_SQ)  { conv_tile(in[I_MWO] + (size_t)j * 1024 * 1024, 1024, 32, r, (bf16_t*)(wm + W_MLA_O), 1024, 0, MAP_ID, 0, scr, C.lane); done = true; break; } r -= T_SQ;
        }
        if (done) continue;
        unsigned char* wr = (unsigned char*)WB + W_RW;
        bf16_t* w1c = (bf16_t*)(wr + W_RW_1);
        JOB(T_SQ, conv_tile(in[I_WR], 1024, 32, r, w1c, 1024, 0, MAP_ID, 0, scr, C.lane));
        JOB(T_SQ, conv_tile(in[I_WK], 1024, 32, r, w1c, 1024, 0, MAP_ID, 1024, scr, C.lane));
        JOB(T_SQ, conv_tile(in[I_WV], 1024, 32, r, w1c, 1024, 0, MAP_ID, 2048, scr, C.lane));
        JOB(T_W1, conv_tile(in[I_W1], 64, 2, r, w1c, 1024, 0, MAP_ID, 3072, scr, C.lane));
        JOB(T_W1, conv_tile(in[I_W1] + 1024 * 64, 64, 2, r, w1c, 1024, 0, MAP_ID, 3072 + 64, scr, C.lane));
        JOB(T_W1, conv_tile(in[I_A1], 64, 2, r, w1c, 1024, 0, MAP_ID, 3328, scr, C.lane));
        JOB(T_W1, conv_tile(in[I_A1] + 1024 * 64, 64, 2, r, w1c, 1024, 0, MAP_ID, 3328 + 64, scr, C.lane));
        JOB(T_G1, conv_tile(in[I_G1], 128, 4, r, w1c, 1024, 0, MAP_ID, 3584, scr, C.lane));
        JOB(T_G2, conv_tile(in[I_G2], 1024, 32, r, (bf16_t*)(wr + W_RW_G2T), 256, 0, MAP_ID, 0, scr, C.lane));
        JOB(T_SQ, conv_tile(in[I_RWO], 1024, 32, r, (bf16_t*)(wr + W_RW_O), 1024, 0, MAP_ID, 0, scr, C.lane));
        JOB(T_PW, conv_tile(in[I_POOLW] + 0 * 65536, 256, 8, r, (bf16_t*)((unsigned char*)WB + W_POOL), 256, 0, MAP_ID, 0, scr, C.lane));
        JOB(T_PW, conv_tile(in[I_POOLW] + 1 * 65536, 256, 8, r, (bf16_t*)((unsigned char*)WB + W_POOL), 256, 0, MAP_ID, 256, scr, C.lane));
        JOB(T_PW, conv_tile(in[I_POOLW] + 2 * 65536, 256, 8, r, (bf16_t*)((unsigned char*)WB + W_POOL), 256, 0, MAP_ID, 512, scr, C.lane));
        JOB(T_PW, conv_tile(in[I_POOLW] + 3 * 65536, 256, 8, r, (bf16_t*)((unsigned char*)WB + W_POOL), 256, 0, MAP_ID, 768, scr, C.lane));
        JOB(T_W2, conv_tile(in[I_W2], 1024, 32, r, (bf16_t*)(wr + W_RW_W2T), 64, 0, MAP_ID, 0, scr, C.lane));
        JOB(T_W2, conv_tile(in[I_W2] + 64 * 1024, 1024, 32, r, (bf16_t*)(wr + W_RW_W2T), 64, 0, MAP_ID, 1024, scr, C.lane));
        JOB(T_W2, conv_tile(in[I_A2], 1024, 32, r, (bf16_t*)(wr + W_RW_A2T), 64, 0, MAP_ID, 0, scr, C.lane));
        JOB(T_W2, conv_tile(in[I_A2] + 64 * 1024, 1024, 32, r, (bf16_t*)(wr + W_RW_A2T), 64, 0, MAP_ID, 1024, scr, C.lane));
        JOB(96 * 1024 / 8 / 64, zero_rect_item((bf16_t*)((unsigned char*)WB + W_MLA + W_MLA_1), 1024, 672, 0, 1024, r, C.lane));
        JOB(96 * 1024 / 8 / 64, zero_rect_item((bf16_t*)((unsigned char*)WB + W_MLA + W_MLA_STRIDE + W_MLA_1), 1024, 672, 0, 1024, r, C.lane));
        JOB(128 * 1024 / 8 / 64, zero_rect_item(w1c, 1024, 3200, 0, 1024, r, C.lane));
        JOB(128 * 1024 / 8 / 64, zero_rect_item(w1c, 1024, 3456, 0, 1024, r, C.lane));
        JOB(128 * 1024 / 8 / 64, zero_rect_item(w1c, 1024, 3712, 0, 1024, r, C.lane));
        JOB(1024 * 128 / 8 / 64, zero_rect_item((bf16_t*)(wr + W_RW_G2T), 256, 0, 128, 128, r, C.lane));
    }
}

__device__ __forceinline__ void store_h_row(bf16_t* Hrow, const f32x4 (&x)[4], const float* sh, const float* sc, int lane) {
#pragma unroll
    for (int j = 0; j < 4; ++j) { const int c = 4 * lane + 256 * j; const f32x4 s = *(const f32x4*)(sc + c), t = *(const f32x4*)(sh + c);
        u32x2 o; o.x = pk2(x[j].x * (1.f + s.x) + t.x, x[j].y * (1.f + s.y) + t.y); o.y = pk2(x[j].z * (1.f + s.z) + t.z, x[j].w * (1.f + s.w) + t.w);
        *(u32x2*)(Hrow + c) = o; }
}
__device__ __forceinline__ void phase_init(const Ctx& C) {
    unsigned char* ws = C.a->ws; float* X = (float*)(ws + WS_X); bf16_t* H = (bf16_t*)(ws + WS_H); const float* MOD = (const float*)(ws + WS_MOD);
    for (int row = C.gw; row < MROWS; row += C.NGW) {
        const float* src = row < NPR ? C.a->in[I_XP] + (size_t)row * DM : C.a->in[I_XS] + (size_t)(row - NPR) * DM;
        f32x4 x[4];
#pragma unroll
        for (int j = 0; j < 4; ++j) { x[j] = *(const f32x4*)(src + 4 * C.lane + 256 * j); *(f32x4*)(X + (size_t)row * DM + 4 * C.lane + 256 * j) = x[j]; }
        const int cd = cond_of_row(row);
        store_h_row(H + (size_t)row * DM, x, modp(MOD, 0, cd, 0), modp(MOD, 0, cd, 1), C.lane);
    }
}
__device__ __forceinline__ void phase_ln(const Ctx& C, int layer, int which, int hl, int hs, bool to_out) {
    unsigned char* ws = C.a->ws; float* X = (float*)(ws + WS_X); bf16_t* H = (bf16_t*)(ws + WS_H); const float* MOD = (const float*)(ws + WS_MOD);
    const float* g = C.a->in[I_LNG] + (size_t)(layer * 2 + which) * DM; const float* b = C.a->in[I_LNB] + (size_t)(layer * 2 + which) * DM;
    for (int row = C.gw; row < MROWS; row += C.NGW) {
        float* xr = X + (size_t)row * DM; f32x4 x[4]; float s = 0.f;
#pragma unroll
        for (int j = 0; j < 4; ++j) { x[j] = *(const f32x4*)(xr + 4 * C.lane + 256 * j); s += (x[j].x + x[j].y) + (x[j].z + x[j].w); }
        const float mean = wave_sum(s) * (1.f / DM); float q = 0.f;
#pragma unroll
        for (int j = 0; j < 4; ++j) { x[j] = x[j] - mean; q += (x[j].x * x[j].x + x[j].y * x[j].y) + (x[j].z * x[j].z + x[j].w * x[j].w); }
        const float rstd = 1.0f / sqrtf(wave_sum(q) * (1.f / DM) + 1e-5f);
#pragma unroll
        for (int j = 0; j < 4; ++j) { const int c = 4 * C.lane + 256 * j; const f32x4 gg = *(const f32x4*)(g + c), bb = *(const f32x4*)(b + c);
            x[j] = x[j] * rstd * gg + bb; *(f32x4*)(xr + c) = x[j];
            if (to_out) *(f32x4*)(C.a->out + (size_t)row * DM + c) = x[j]; }
        if (hs >= 0) { const int cd = cond_of_row(row); store_h_row(H + (size_t)row * DM, x, modp(MOD, hl, cd, hs), modp(MOD, hl, cd, hs + 1), C.lane); }
    }
}

template <class ASel, class Epi>
__device__ __forceinline__ void gemm_simple(const Ctx& C, const ASel& asel, int lda, const bf16_t* Bt, int ldb, int Mr, int N, int K, const Epi& epi) {
    const int nTm = Mr >> 6, nTn = N >> 6, fr = C.lane & 15, fq = C.lane >> 4;
    for (int t = C.gw; t < nTm * nTn; t += C.NGW) {
        const int tm = t / nTn, tn = t - tm * nTn, m0 = tm * 64, n0 = tn * 64;
        const bf16_t* A = asel(n0);
        f32x4 acc[4][2][2];
#pragma unroll
        for (int mi = 0; mi < 4; ++mi)
#pragma unroll
            for (int g = 0; g < 2; ++g) { acc[mi][g][0] = (f32x4){0.f, 0.f, 0.f, 0.f}; acc[mi][g][1] = (f32x4){0.f, 0.f, 0.f, 0.f}; }
        const bf16_t* ap = A + (size_t)(m0 + fr) * lda + 8 * fq;
        const bf16_t* bp0 = Bt + (size_t)(n0 + perm32(fr)) * ldb + 8 * fq;
        const bf16_t* bp1 = Bt + (size_t)(n0 + perm32(16 + fr)) * ldb + 8 * fq;
        for (int k0 = 0; k0 < K; k0 += 32) {
            bf16x8 af[4], bf[2][2];
#pragma unroll
            for (int mi = 0; mi < 4; ++mi) af[mi] = *(const bf16x8*)(ap + (size_t)(16 * mi) * lda + k0);
#pragma unroll
            for (int g = 0; g < 2; ++g) { bf[g][0] = *(const bf16x8*)(bp0 + (size_t)(32 * g) * ldb + k0); bf[g][1] = *(const bf16x8*)(bp1 + (size_t)(32 * g) * ldb + k0); }
#pragma unroll
            for (int mi = 0; mi < 4; ++mi)
#pragma unroll
                for (int g = 0; g < 2; ++g) {
                    acc[mi][g][0] = __builtin_amdgcn_mfma_f32_16x16x32_bf16(bf[g][0], af[mi], acc[mi][g][0], 0, 0, 0);
                    acc[mi][g][1] = __builtin_amdgcn_mfma_f32_16x16x32_bf16(bf[g][1], af[mi], acc[mi][g][1], 0, 0, 0);
                }
        }
#pragma unroll
        for (int mi = 0; mi < 4; ++mi)
#pragma unroll
            for (int g = 0; g < 2; ++g) epi(m0 + 16 * mi + fr, n0 + 32 * g + 8 * fq, acc[mi][g][0], acc[mi][g][1]);
    }
}
struct ASelPlain { const bf16_t* A; __device__ __forceinline__ const bf16_t* operator()(int) const { return A; } };
struct ASelShift { const bf16_t* A; int shift; size_t stride; __device__ __forceinline__ const bf16_t* operator()(int n0) const { return A + (size_t)(n0 >> shift) * stride; } };

struct EpiF32 { float* out; int ldc;
    __device__ __forceinline__ void operator()(int row, int c0, f32x4 v0, f32x4 v1) const { float* o = out + (size_t)row * ldc + c0; *(f32x4*)o = v0; *(f32x4*)(o + 4) = v1; } };
struct EpiBf16 { bf16_t* out; int ldc;
    __device__ __forceinline__ void operator()(int row, int c0, f32x4 v0, f32x4 v1) const {
        u32x4 w; w.x = pk2(v0.x, v0.y); w.y = pk2(v0.z, v0.w); w.z = pk2(v1.x, v1.y); w.w = pk2(v1.z, v1.w); *(u32x4*)(out + (size_t)row * ldc + c0) = w; } };
struct EpiSwiglu { bf16_t* act;
    __device__ __forceinline__ void operator()(int row, int c0, f32x4 v0, f32x4 v1) const {
        u32x2 w; w.x = pk2(siluf_(v0.x) * v1.x, siluf_(v0.y) * v1.y); w.y = pk2(siluf_(v0.z) * v1.z, siluf_(v0.w) * v1.w);
        *(u32x2*)(act + (size_t)row * DFF + (c0 >> 1)) = w; } };
struct EpiResid { float* X; const float* MOD; int layer, gslot; const float* cscale;
    __device__ __forceinline__ void operator()(int row, int c0, f32x4 v0, f32x4 v1) const {
        const float* gt = modp(MOD, layer, cond_of_row(row), gslot) + c0; float* x = X + (size_t)row * DM + c0;
        f32x4 g0 = *(const f32x4*)gt, g1 = *(const f32x4*)(gt + 4);
        if (cscale) { g0 = g0 * *(const f32x4*)(cscale + c0); g1 = g1 * *(const f32x4*)(cscale + c0 + 4); }
        const f32x4 x0 = *(const f32x4*)x, x1 = *(const f32x4*)(x + 4);
        *(f32x4*)x = x0 * ALPHA + g0 * v0; *(f32x4*)(x + 4) = x1 * ALPHA + g1 * v1; } };
struct EpiRwA { bf16_t* R;
    __device__ __forceinline__ void operator()(int row, int c0, f32x4 v0, f32x4 v1) const {
        u32x4 w; w.x = pk2(v0.x, v0.y); w.y = pk2(v0.z, v0.w); w.z = pk2(v1.x, v1.y); w.w = pk2(v1.z, v1.w);
        *(u32x4*)(R + (size_t)(c0 >> 10) * ((size_t)MROWS * DM) + (size_t)row * DM + (c0 & 1023)) = w; } };
struct EpiRwB { bf16_t* T2; bf16_t* SG;
    __device__ __forceinline__ void operator()(int row, int c0, f32x4 v0, f32x4 v1) const {
        const int tile = c0 >> 8, cc = c0 & 255;
        if (tile == 0) { if (cc >= 128) return;
            u32x4 w; w.x = pk2(tanhf(v0.x), tanhf(v0.y)); w.y = pk2(tanhf(v0.z), tanhf(v0.w)); w.z = pk2(tanhf(v1.x), tanhf(v1.y)); w.w = pk2(tanhf(v1.z), tanhf(v1.w));
            *(u32x4*)(T2 + (size_t)row * 256 + cc) = w; }
        else if (tile == 1) { if (cc >= 128) return;
            u32x4 w; w.x = pk2(v0.x, v0.y); w.y = pk2(v0.z, v0.w); w.z = pk2(v1.x, v1.y); w.w = pk2(v1.z, v1.w);
            *(u32x4*)(T2 + (size_t)row * 256 + 128 + cc) = w; }
        else { u32x4 w; w.x = pk2(sigmoidf_(v0.x), sigmoidf_(v0.y)); w.y = pk2(sigmoidf_(v0.z), sigmoidf_(v0.w)); w.z = pk2(sigmoidf_(v1.x), sigmoidf_(v1.y)); w.w = pk2(sigmoidf_(v1.z), sigmoidf_(v1.w));
            *(u32x4*)(SG + (size_t)row * 256 + cc) = w; } } };
__device__ __forceinline__ int kv_row_of(int row) { return row < NPR ? row : NPR + ((row - NPR) >> 12) * 4608 + 512 + ((row - NPR) & 4095); }
__device__ __forceinline__ void phase_mla_norm(const Ctx& C, int j) {
    unsigned char* ws = C.a->ws; const float* R1 = (const float*)(ws + WS_SCR + S_R1);
    bf16_t* QA = (bf16_t*)(ws + WS_SCR + S_QA); bf16_t* CKV = (bf16_t*)(ws + WS_SCR + S_CKV); bf16_t* KPE = (bf16_t*)(ws + WS_SCR + S_KPE);
    const float* ROPE = (const float*)(ws + WS_ROPE);
    const float* qn = C.a->in[I_QNORM] + j * 384; const float* kvn = C.a->in[I_KVNORM] + j * 256; float* out = C.a->out;
    const int lane = C.lane;
    for (int row = C.gw; row < MROWS + 1024; row += C.NGW) {
        if (row < MROWS) {
            const float* r = R1 + (size_t)row * 768;
            f32x2 q[3]; float s = 0.f;
#pragma unroll
            for (int jj = 0; jj < 3; ++jj) { q[jj] = *(const f32x2*)(r + 2 * lane + 128 * jj); s += q[jj].x * q[jj].x + q[jj].y * q[jj].y; }
            const float rstd = 1.0f / sqrtf(wave_sum(s) * (1.f / 384.f) + 1e-6f);
#pragma unroll
            for (int jj = 0; jj < 3; ++jj) { const int c = 2 * lane + 128 * jj; const f32x2 g = *(const f32x2*)(qn + c);
                *(unsigned*)(QA + (size_t)row * 384 + c) = pk2(q[jj].x * rstd * g.x, q[jj].y * rstd * g.y); }
            const f32x4 kv = *(const f32x4*)(r + 384 + 4 * lane);
            const float rstd2 = 1.0f / sqrtf(wave_sum((kv.x * kv.x + kv.y * kv.y) + (kv.z * kv.z + kv.w * kv.w)) * (1.f / 256.f) + 1e-6f);
            const f32x4 o = kv * rstd2 * *(const f32x4*)(kvn + 4 * lane);
            const int kvrow = kv_row_of(row);
            u32x2 w; w.x = pk2(o.x, o.y); w.y = pk2(o.z, o.w);
            *(u32x2*)(CKV + (size_t)kvrow * 256 + 4 * lane) = w;
            const int b = row >> 8, t = row & 255;
            if (row < NPR) *(f32x4*)(out + OUT_CKV + ((size_t)(b * 2 + j) * 256 + t) * 256 + 4 * lane) = o;
            if (lane < 16) {
                const int p = lane, ax = p >> 3, f = p & 7;
                float x1 = r[640 + 2 * p], x2 = r[640 + 2 * p + 1];
                if (row < NPR) { float* ok = out + OUT_KPE + ((size_t)(b * 2 + j) * 256 + t) * 32 + ax * 16 + f; ok[0] = x1; ok[8] = x2; }
                else { const int tt = (row - NPR) & 4095; const int pos = ax == 0 ? (tt >> 6) : (tt & 63);
                    const float c = ROPE[pos * 8 + f], sn = ROPE[512 + pos * 8 + f]; const float o1 = x1 * c - x2 * sn, o2 = x1 * sn + x2 * c; x1 = o1; x2 = o2; }
                *(unsigned*)(KPE + (size_t)kvrow * 32 + 2 * p) = pk2(x1, x2);
            }
        } else {
            const int idx = row - MROWS, b = idx >> 9, i = idx & 511; const int kvrow = NPR + b * 4608 + i;
            const float* sc = C.a->in[I_CCKV] + ((size_t)(b * 2 + j) * 512 + i) * 256;
            const f32x4 v = *(const f32x4*)(sc + 4 * lane);
            u32x2 w; w.x = pk2(v.x, v.y); w.y = pk2(v.z, v.w);
            *(u32x2*)(CKV + (size_t)kvrow * 256 + 4 * lane) = w;
            if (lane < 16) { const int p = lane, ax = p >> 3, f = p & 7; const float* sk = C.a->in[I_CKPE] + ((size_t)(b * 2 + j) * 512 + i) * 32 + ax * 16 + f;
                *(unsigned*)(KPE + (size_t)kvrow * 32 + 2 * p) = pk2(sk[0], sk[8]); }
        }
    }
}

#define RDL(v, i) __builtin_bit_cast(float, __builtin_amdgcn_readlane(__builtin_bit_cast(int, (v)), (i)))
__device__ __forceinline__ void phase_attn_simple(const Ctx& C) {
    unsigned char* ws = C.a->ws; const bf16_t* Q = (const bf16_t*)(ws + WS_SCR + S_Q); const bf16_t* KV = (const bf16_t*)(ws + WS_SCR + S_KV);
    const bf16_t* KPE = (const bf16_t*)(ws + WS_SCR + S_KPE); bf16_t* O = (bf16_t*)(ws + WS_SCR + S_O); const float* ROPE = (const float*)(ws + WS_ROPE);
    const int lane = C.lane; const float scale = 0.10206207261596577f;
    for (int it = C.gw; it < MROWS * 16; it += C.NGW) {
        const int row = it >> 4, h = it & 15;
        int kbase, ntile;
        if (row < NPR) { kbase = row & ~255; ntile = 4; } else { kbase = NPR + ((row - NPR) >> 12) * 4608; ntile = 72; }
        const bf16_t* qrow = Q + (size_t)row * 1536 + h * 96;
        float qa = bf2f(qrow[lane]); float qb = bf2f(qrow[64 + (lane & 31)]);
        if (row >= NPR) { const int tt = (row - NPR) & 4095; const int p = (lane & 31) >> 1, ax = p >> 3, f = p & 7; const int pos = ax == 0 ? (tt >> 6) : (tt & 63);
            const float c = ROPE[pos * 8 + f], sn = ROPE[512 + pos * 8 + f]; const float other = __shfl_xor(qb, 1);
            qb = (lane & 1) ? (other * sn + qb * c) : (qb * c - other * sn); }
        qa *= scale; qb *= scale;
        float m = -1e30f, l = 0.f, acc = 0.f;
        for (int tile = 0; tile < ntile; ++tile) {
            const int key = kbase + tile * 64 + lane;
            const u32x4* kn = (const u32x4*)(KV + (size_t)key * 2048 + h * 128); const u32x4* kp = (const u32x4*)(KPE + (size_t)key * 32);
            float s = 0.f;
#pragma unroll
            for (int c8 = 0; c8 < 8; ++c8) { const u32x4 w = kn[c8];
                s = fmaf(RDL(qa, 8 * c8 + 0), bflo(w.x), s); s = fmaf(RDL(qa, 8 * c8 + 1), bfhi(w.x), s); s = fmaf(RDL(qa, 8 * c8 + 2), bflo(w.y), s); s = fmaf(RDL(qa, 8 * c8 + 3), bfhi(w.y), s);
                s = fmaf(RDL(qa, 8 * c8 + 4), bflo(w.z), s); s = fmaf(RDL(qa, 8 * c8 + 5), bfhi(w.z), s); s = fmaf(RDL(qa, 8 * c8 + 6), bflo(w.w), s); s = fmaf(RDL(qa, 8 * c8 + 7), bfhi(w.w), s); }
#pragma unroll
            for (int c8 = 0; c8 < 4; ++c8) { const u32x4 w = kp[c8];
                s = fmaf(RDL(qb, 8 * c8 + 0), bflo(w.x), s); s = fmaf(RDL(qb, 8 * c8 + 1), bfhi(w.x), s); s = fmaf(RDL(qb, 8 * c8 + 2), bflo(w.y), s); s = fmaf(RDL(qb, 8 * c8 + 3), bfhi(w.y), s);
                s = fmaf(RDL(qb, 8 * c8 + 4), bflo(w.z), s); s = fmaf(RDL(qb, 8 * c8 + 5), bfhi(w.z), s); s = fmaf(RDL(qb, 8 * c8 + 6), bflo(w.w), s); s = fmaf(RDL(qb, 8 * c8 + 7), bfhi(w.w), s); }
            const float mn = fmaxf(m, wave_max(s)); const float alpha = __expf(m - mn); const float p = __expf(s - mn);
            l = l * alpha + wave_sum(p); acc *= alpha; m = mn;
            const bf16_t* vb = KV + (size_t)(kbase + tile * 64) * 2048 + h * 128 + 64 + lane;
#pragma unroll 16
            for (int jj = 0; jj < 64; ++jj) acc = fmaf(RDL(p, jj), bf2f(vb[(size_t)jj * 2048]), acc);
        }
        O[(size_t)row * 1024 + h * 64 + lane] = (bf16_t)f2bf(acc / l);
    }
}

__device__ __forceinline__ void phase_rw_prep(const Ctx& C, int layer, int part) {
    unsigned char* ws = C.a->ws; const float* X = (const float*)(ws + WS_X); bf16_t* XA = (bf16_t*)(ws + WS_H + R_XA); const float* MOD = (const float*)(ws + WS_MOD);
    const float* mu = C.a->in[I_MU]; const int lane = C.lane;
    const int i0 = part == 0 ? 0 : 1, i1 = part == 0 ? 2 : 4, i2 = part == 0 ? 3 : 5;
    for (int row = C.gw; row < MROWS; row += C.NGW) {
        int t, T; if (row < NPR) { t = row & 255; T = 256; } else { t = (row - NPR) & 4095; T = 4096; }
        const int cd = cond_of_row(row); const float* sh = modp(MOD, layer, cd, 0); const float* sc = modp(MOD, layer, cd, 1);
        const float* xr = X + (size_t)row * DM;
#pragma unroll
        for (int j = 0; j < 4; ++j) { const int c = 4 * lane + 256 * j;
            const f32x4 s1 = *(const f32x4*)(sc + c) + 1.0f, s0 = *(const f32x4*)(sh + c);
            const f32x4 h = *(const f32x4*)(xr + c) * s1 + s0;
            f32x4 hp = (f32x4){0.f, 0.f, 0.f, 0.f}, hn = (f32x4){0.f, 0.f, 0.f, 0.f};
            if (t > 0) hp = *(const f32x4*)(xr - DM + c) * s1 + s0;
            if (t < T - 1) hn = *(const f32x4*)(xr + DM + c) * s1 + s0;
            const f32x4 xx = (hp + hn) * 0.5f - h;
            const f32x4 o0 = h + xx * *(const f32x4*)(mu + i0 * DM + c), o1 = h + xx * *(const f32x4*)(mu + i1 * DM + c), o2 = h + xx * *(const f32x4*)(mu + i2 * DM + c);
            u32x2 w; w.x = pk2(o0.x, o0.y); w.y = pk2(o0.z, o0.w); *(u32x2*)(XA + (size_t)row * DM + c) = w;
            w.x = pk2(o1.x, o1.y); w.y = pk2(o1.z, o1.w); *(u32x2*)(XA + (size_t)MROWS * DM + (size_t)row * DM + c) = w;
            w.x = pk2(o2.x, o2.y); w.y = pk2(o2.z, o2.w); *(u32x2*)(XA + (size_t)2 * MROWS * DM + (size_t)row * DM + c) = w; }
    }
}

__device__ __forceinline__ float dpp_x1(float v) { return __builtin_bit_cast(float, __builtin_amdgcn_mov_dpp(__builtin_bit_cast(int, v), 0xB1, 0xF, 0xF, true)); }
__device__ __forceinline__ float dpp_x2(float v) { return __builtin_bit_cast(float, __builtin_amdgcn_mov_dpp(__builtin_bit_cast(int, v), 0x4E, 0xF, 0xF, true)); }

constexpr int SCAN_BLK = 8;
__device__ __forceinline__ void scan_item(const Ctx& C, int row_first, int T, int h, int dir, int init, const float* initp, bool hasv, bf16_t* yout, float* endp, float* bon) {
    unsigned char* ws = C.a->ws; const float* const* in = C.a->in;
    const bf16_t* Rb = (const bf16_t*)(ws + WS_H + R_R); const bf16_t* Kb = (const bf16_t*)(ws + WS_H + R_K); const bf16_t* Vb = (const bf16_t*)(ws + WS_H + R_V);
    const bf16_t* T2 = (const bf16_t*)(ws + WS_H + R_T2);
    LAS float* opb = (LAS float*)(C.lds + C.wave * 16384);
    const int lane = C.lane, ks = lane & 3, vg = lane >> 2, ch = h * 64 + lane;
    const float w0c = in[I_W0][dir * DM + ch], a0c = in[I_A0][dir * DM + ch], kkc = in[I_KK][ch], kac = in[I_KA][ch], rkc = in[I_RK][ch];
    const float* w2p = in[I_W2] + (size_t)dir * 64 * DM + ch; const float* a2p = in[I_A2] + (size_t)dir * 64 * DM + ch;
    float S[4][16];
#pragma unroll
    for (int i = 0; i < 4; ++i)
#pragma unroll
        for (int j = 0; j < 16; ++j) S[i][j] = (init == 1) ? ((4 * vg + i == 16 * ks + j) ? 1.f : 0.f) : 0.f;
    if (init == 2) {
#pragma unroll
        for (int i = 0; i < 4; ++i)
#pragma unroll
            for (int q = 0; q < 4; ++q) { const f32x4 v = *(const f32x4*)(initp + (4 * vg + i) * 64 + 16 * ks + 4 * q); S[i][4 * q] = v.x; S[i][4 * q + 1] = v.y; S[i][4 * q + 2] = v.z; S[i][4 * q + 3] = v.w; }
    }
    for (int s0 = 0; s0 < T; s0 += SCAN_BLK) {
#pragma unroll 1
        for (int s = 0; s < SCAN_BLK; ++s) {
            const int row = dir == 0 ? row_first + s0 + s : row_first + T - 1 - (s0 + s);
            const float r = bf2f(Rb[(size_t)row * DM + ch]), k = bf2f(Kb[(size_t)row * DM + ch]), v = bf2f(Vb[(size_t)row * DM + ch]);
            const float tw = bf2f(T2[(size_t)row * 256 + dir * 64 + lane]), ta = bf2f(T2[(size_t)row * 256 + 128 + dir * 64 + lane]);
            float wpre = 0.f, apre = 0.f;
#pragma unroll 8
            for (int j = 0; j < 64; ++j) { wpre = fmaf(RDL(tw, j), w2p[(size_t)j * DM], wpre); apre = fmaf(RDL(ta, j), a2p[(size_t)j * DM], apre); }
            const float w = __expf(-0.6065306597126334f * sigmoidf_(w0c + wpre));
            const float a = sigmoidf_(a0c + apre);
            const float kkr = k * kkc; const float nrm = sqrtf(wave_sum(kkr * kkr)); const float kk = kkr / fmaxf(nrm, 1e-12f);
            const float kd = k * (1.0f + (a - 1.0f) * kac);
            const float bsum = wave_sum(r * kd * rkc);
            if (bon && lane == 0) bon[(size_t)row * 16 + h] = bsum;
            LAS float* o = opb + s * 384;
            o[lane] = -kk; o[64 + lane] = w; o[128 + lane] = kk * a; o[192 + lane] = kd; o[256 + lane] = r; o[320 + lane] = hasv ? v : 0.f;
        }
        asm volatile("s_waitcnt lgkmcnt(0)" ::: "memory");
#pragma unroll 1
        for (int s = 0; s < SCAN_BLK; ++s) {
            const int row = dir == 0 ? row_first + s0 + s : row_first + T - 1 - (s0 + s);
            const LAS float* o = opb + s * 384;
            float av[16], wv[16], bv[16], kv[16], rv[16];
#pragma unroll
            for (int q = 0; q < 4; ++q) {
                const f32x4 x0 = *(const LAS f32x4*)(o + 16 * ks + 4 * q), x1 = *(const LAS f32x4*)(o + 64 + 16 * ks + 4 * q), x2 = *(const LAS f32x4*)(o + 128 + 16 * ks + 4 * q),
                            x3 = *(const LAS f32x4*)(o + 192 + 16 * ks + 4 * q), x4 = *(const LAS f32x4*)(o + 256 + 16 * ks + 4 * q);
                av[4 * q] = x0.x; av[4 * q + 1] = x0.y; av[4 * q + 2] = x0.z; av[4 * q + 3] = x0.w;
                wv[4 * q] = x1.x; wv[4 * q + 1] = x1.y; wv[4 * q + 2] = x1.z; wv[4 * q + 3] = x1.w;
                bv[4 * q] = x2.x; bv[4 * q + 1] = x2.y; bv[4 * q + 2] = x2.z; bv[4 * q + 3] = x2.w;
                kv[4 * q] = x3.x; kv[4 * q + 1] = x3.y; kv[4 * q + 2] = x3.z; kv[4 * q + 3] = x3.w;
                rv[4 * q] = x4.x; rv[4 * q + 1] = x4.y; rv[4 * q + 2] = x4.z; rv[4 * q + 3] = x4.w;
            }
            const f32x4 vv4 = *(const LAS f32x4*)(o + 320 + 4 * vg); const float vv[4] = {vv4.x, vv4.y, vv4.z, vv4.w};
            float y[4];
#pragma unroll
            for (int i = 0; i < 4; ++i) {
                float sa = 0.f;
#pragma unroll
                for (int j = 0; j < 16; ++j) sa = fmaf(S[i][j], av[j], sa);
                sa += dpp_x1(sa); sa += dpp_x2(sa);
                float yy = 0.f;
#pragma unroll
                for (int j = 0; j < 16; ++j) { S[i][j] = fmaf(S[i][j], wv[j], fmaf(sa, bv[j], vv[i] * kv[j])); yy = fmaf(S[i][j], rv[j], yy); }
                yy += dpp_x1(yy); yy += dpp_x2(yy); y[i] = yy;
            }
            const float yo = ks == 0 ? y[0] : ks == 1 ? y[1] : ks == 2 ? y[2] : y[3];
            yout[(size_t)row * DM + h * 64 + lane] = (bf16_t)f2bf(yo);
        }
        asm volatile("s_waitcnt lgkmcnt(0)" ::: "memory");
    }
    if (endp) {
#pragma unroll
        for (int i = 0; i < 4; ++i)
#pragma unroll
            for (int q = 0; q < 4; ++q) *(f32x4*)(endp + (4 * vg + i) * 64 + 16 * ks + 4 * q) = (f32x4){S[i][4 * q], S[i][4 * q + 1], S[i][4 * q + 2], S[i][4 * q + 3]};
    }
}
__device__ __forceinline__ void phase_rw_scan_seq(const Ctx& C) {
    unsigned char* ws = C.a->ws; bf16_t* Y = (bf16_t*)(ws + WS_H + R_Y); float* BON = (float*)(ws + WS_H + R_BON);
    for (int it = C.gw; it < 1088; it += C.NGW) {
        if (it < 64) { const int b = it >> 5, h = (it >> 1) & 15, dir = it & 1;
            scan_item(C, NPR + b * 4096, 4096, h, dir, 2, C.a->in[I_SWKV] + ((size_t)(b * 2 + dir) * 16 + h) * 4096, true, Y + (size_t)dir * MROWS * DM, nullptr, BON + (size_t)dir * MROWS * 16);
        } else { const int q = it - 64, b = q >> 5, h = (q >> 1) & 15, dir = q & 1;
            scan_item(C, b * 256, 256, h, dir, 0, nullptr, true, Y + (size_t)dir * MROWS * DM, C.a->out + OUT_WKV + ((size_t)(b * 2 + dir) * 16 + h) * 4096, BON + (size_t)dir * MROWS * 16); }
    }
}
__device__ __forceinline__ void phase_rw_post(const Ctx& C) {
    unsigned char* ws = C.a->ws; bf16_t* Y0 = (bf16_t*)(ws + WS_H + R_Y); const bf16_t* Y1 = Y0 + (size_t)MROWS * DM; const float* BON = (const float*)(ws + WS_H + R_BON);
    const bf16_t* Vb = (const bf16_t*)(ws + WS_H + R_V); const bf16_t* G = (const bf16_t*)(ws + WS_H + R_G);
    const float* lg = C.a->in[I_LNXG]; const float* lb = C.a->in[I_LNXB]; const int lane = C.lane;
    for (int it = C.gw; it < MROWS * 16; it += C.NGW) {
        const int row = it >> 4, h = it & 15, c = h * 64 + lane; const size_t e = (size_t)row * DM + c;
        const float y = bf2f(Y0[e]) + bf2f(Y1[e]);
        const float mean = wave_sum(y) * (1.f / 64.f); const float d = y - mean; const float var = wave_sum(d * d) * (1.f / 64.f);
        const float yn = d * (1.0f / sqrtf(var + 64e-5f)) * lg[c] + lb[c];
        const float bonus = (BON[(size_t)row * 16 + h] + BON[(size_t)MROWS * 16 + (size_t)row * 16 + h]) * bf2f(Vb[e]);
        Y0[e] = (bf16_t)f2bf((yn + bonus) * bf2f(G[e]));
    }
}

__device__ __forceinline__ void phase_pool_prep(const Ctx& C, int layer) {
    unsigned char* ws = C.a->ws; const float* X = (const float*)(ws + WS_X); bf16_t* P = (bf16_t*)(ws + WS_SCR + S_POOL); const float* MOD = (const float*)(ws + WS_MOD);
    const int lane = C.lane;
    for (int row = C.gw; row < MROWS; row += C.NGW) {
        int t, T; if (row < NPR) { t = row & 255; T = 256; } else { t = (row - NPR) & 4095; T = 4096; }
        const float* sc = modp(MOD, layer, cond_of_row(row), 1); const float* xr = X + (size_t)row * DM;
#pragma unroll
        for (int j = 0; j < 4; ++j) { const int c = 4 * lane + 256 * j; const int win = 2 << j;
            int lo = t - win / 2, hi = t - win / 2 + win; lo = lo < 0 ? 0 : lo; hi = hi > T ? T : hi;
            f32x4 s = (f32x4){0.f, 0.f, 0.f, 0.f};
            for (int u = lo; u < hi; ++u) s = s + *(const f32x4*)(xr + (ptrdiff_t)(u - t) * DM + c);
            const f32x4 o = (*(const f32x4*)(sc + c) + 1.0f) * (s * (1.0f / (float)(hi - lo)) - *(const f32x4*)(xr + c));
            u32x2 w; w.x = pk2(o.x, o.y); w.y = pk2(o.z, o.w); *(u32x2*)(P + (size_t)row * DM + c) = w; }
    }
}
namespace pg8 {
#define PG8_LAS __attribute__((address_space(3)))
constexpr int BM = 256, BK = 64, HALF = 128, HTB = HALF * BK * 2, STAGE_BYTES = 8 * HTB, NXCD = 8, WGM = 8;
__host__ __device__ __forceinline__ int lds_byte(int r, int c) { const int st = (r >> 4) * 2 + (c >> 5), rr = r & 15, cc = c & 31, ob = rr * 64 + cc * 2; return st * 1024 + (ob ^ (((ob >> 9) & 1) << 5)); }
__host__ __device__ __forceinline__ void stage_rc(int b, int& R, int& C) { const int st = b / 1024, sb = b % 1024, swz = sb ^ (((sb >> 9) & 1) << 5); R = (st >> 1) * 16 + swz / 64; C = (st & 1) * 32 + (swz % 64) / 2; }
struct Unit { int pm, pn; };
struct Gemm { const bf16_t* Bt; int lda, ldb, K; };
struct StaticOrder {
    int nM, nN, nwg, G, c;
    __host__ __device__ void init(int M, int N, int G_, int c_) { nM = M / BM; nN = N / BM; nwg = nM * nN; G = G_; c = c_; }
    __host__ __device__ bool next(int i, Unit& u) const {
        const long L = (long)i * G + c; if (L >= nwg) return false;
        int wgid = (int)L; { const int q = nwg / NXCD, r = nwg % NXCD, xcd = wgid % NXCD, off = wgid / NXCD; wgid = (xcd < r ? xcd * (q + 1) : r * (q + 1) + (xcd - r) * q) + off; }
        const int nig = WGM * nN, gid = wgid / nig, fm = gid * WGM, gsz = (nM - fm) < WGM ? (nM - fm) : WGM;
        u.pm = fm + ((wgid % nig) % gsz); u.pn = (wgid % nig) / gsz; return true;
    }
    __device__ __forceinline__ void a_ready(const Unit&) const {}
    __device__ __forceinline__ void done(const Unit&) const {}
};
template <class E8> struct EpiWrap {
    static constexpr bool PERM = true, AFTER_DRAIN = false; E8 e;
    __device__ __forceinline__ void operator()(const f32x4 (&acc)[2][2][4][2], const Unit& u, int wr, int wc, int fr, int fq) const {
#pragma unroll
        for (int ai = 0; ai < 2; ++ai)
#pragma unroll
            for (int m = 0; m < 4; ++m) { const int row = u.pm * BM + ai * HALF + wr * 64 + m * 16 + fr;
#pragma unroll
                for (int bj = 0; bj < 2; ++bj) e(row, u.pn * BM + bj * HALF + wc * 32 + 8 * fq, acc[ai][bj][m][0], acc[ai][bj][m][1]); }
    }
};
template <class Epi, class ASel, class Sched, bool ALIGN_EPI = false, bool SP2 = false>
__device__ __forceinline__ void gemm_phase(PG8_LAS unsigned char* lds, const Gemm g, const ASel& asel, const Sched& S, const Epi& E) {
    const int tid = threadIdx.x, wid = __builtin_amdgcn_readfirstlane(tid >> 6), lane = tid & 63, wr = wid >> 2, wc = wid & 3, fr = lane & 15, fq = lane >> 4;
    const int K = g.K, nt = K / BK;
    unsigned voffA[2], voffB[2];
#pragma unroll
    for (int i = 0; i < 2; ++i) { int R, C; stage_rc(tid * 16 + i * 8192, R, C); const int Rb = Epi::PERM ? ((R & ~31) + perm32(R & 31)) : R;
        voffA[i] = (unsigned)(R * g.lda + C) * 2u; voffB[i] = (unsigned)(Rb * g.ldb + C) * 2u; }
    const size_t kstep = (size_t)(BK * 2);
    const size_t hstepA = (size_t)HALF * g.lda * 2, hstepB = (size_t)HALF * g.ldb * 2;
    const size_t tstepA = 2 * hstepA, tstepB = 2 * hstepB;
    const unsigned ldsw = (unsigned)wid * 1024u;
    const int aoff = lds_byte(wr * 64 + fr, fq * 8), boff = lds_byte(wc * 32 + fr, fq * 8);
#define PG8_SA(b, h) (((b) * 2 + (h)) * HTB)
#define PG8_SB(b, h) ((4 + (b) * 2 + (h)) * HTB)
#define PG8_STAGE(bufoff, gbase, voff) do { _Pragma("unroll") for (int _i = 0; _i < 2; ++_i) \
        __builtin_amdgcn_global_load_lds((const unsigned*)((const char*)(gbase) + (voff)[_i]), (PG8_LAS unsigned*)(lds + (bufoff) + ldsw + _i * 8192), 16, 0, 0); } while (0)
#define PG8_LDA(dst, b, h) do { _Pragma("unroll") for (int m = 0; m < 4; ++m) _Pragma("unroll") for (int k = 0; k < 2; ++k) dst[m][k] = *(const PG8_LAS bf16x8*)(lds + PG8_SA(b, h) + aoff + m * 2048 + k * 1024); } while (0)
#define PG8_LDB(dst, b, h) do { _Pragma("unroll") for (int n = 0; n < 2; ++n) _Pragma("unroll") for (int k = 0; k < 2; ++k) dst[n][k] = *(const PG8_LAS bf16x8*)(lds + PG8_SB(b, h) + boff + n * 2048 + k * 1024); } while (0)
#define PG8_MMA(ai, bj, At, Bt) do { __builtin_amdgcn_s_setprio(1); _Pragma("unroll") for (int m = 0; m < 4; ++m) _Pragma("unroll") for (int n = 0; n < 2; ++n) _Pragma("unroll") for (int k = 0; k < 2; ++k) \
        acc[ai][bj][m][n] = __builtin_amdgcn_mfma_f32_16x16x32_bf16(Bt[n][k], At[m][k], acc[ai][bj][m][n], 0, 0, 0); __builtin_amdgcn_s_setprio(0); } while (0)
#define PG8_WAIT_V(n) asm volatile("s_waitcnt vmcnt(" #n ")" ::: "memory")
#define PG8_WAIT_L(n) asm volatile("s_waitcnt lgkmcnt(" #n ")" ::: "memory")
#define PG8_BAR __builtin_amdgcn_s_barrier()
#define PG8_SCHED __builtin_amdgcn_sched_barrier(0)
    Unit cur, nxt; int ui = 0;
    if (!S.next(0, cur)) return;
    f32x4 acc[2][2][4][2];
#pragma unroll
    for (int a = 0; a < 2; ++a)
#pragma unroll
        for (int b = 0; b < 2; ++b)
#pragma unroll
            for (int m = 0; m < 4; ++m)
#pragma unroll
                for (int n = 0; n < 2; ++n) acc[a][b][m][n] = (f32x4){0.f, 0.f, 0.f, 0.f};
    bf16x8 At[4][2], B0[2][2], B1[2][2];
    const char* cA = (const char*)asel(cur.pn * BM) + (size_t)cur.pm * tstepA; const char* cB = (const char*)g.Bt + (size_t)cur.pn * tstepB;
    S.a_ready(cur);
    if constexpr (SP2) {
        PG8_STAGE(PG8_SB(0, 0), cB, voffB); PG8_STAGE(PG8_SB(0, 1), cB + hstepB, voffB); PG8_STAGE(PG8_SA(0, 0), cA, voffA); PG8_STAGE(PG8_SA(0, 1), cA + hstepA, voffA);
        if (wr == 1) PG8_BAR;
        PG8_WAIT_V(2); PG8_BAR;
        PG8_STAGE(PG8_SB(1, 0), cB + kstep, voffB); PG8_STAGE(PG8_SA(1, 0), cA + kstep, voffA); PG8_STAGE(PG8_SB(1, 1), cB + hstepB + kstep, voffB);
        PG8_WAIT_V(6); PG8_BAR;
    } else {
        PG8_STAGE(PG8_SB(0, 0), cB, voffB); PG8_STAGE(PG8_SA(0, 0), cA, voffA); PG8_STAGE(PG8_SB(0, 1), cB + hstepB, voffB); PG8_STAGE(PG8_SA(0, 1), cA + hstepA, voffA);
        if (wr == 1) PG8_BAR;
        PG8_WAIT_V(4); PG8_BAR;
        PG8_STAGE(PG8_SB(1, 0), cB + kstep, voffB); PG8_STAGE(PG8_SA(1, 0), cA + kstep, voffA); PG8_STAGE(PG8_SB(1, 1), cB + hstepB + kstep, voffB);
        PG8_WAIT_V(6); PG8_BAR;
    }
    for (;;) {
        const bool has_next = S.next(ui + 1, nxt);
        const char* nA = has_next ? (const char*)asel(nxt.pn * BM) + (size_t)nxt.pm * tstepA : cA; const char* nB = has_next ? (const char*)g.Bt + (size_t)nxt.pn * tstepB : cB;
        for (int t = 0; t < nt; t += 2) {
            const bool last = (t == nt - 2);
            const char* a1 = cA + (size_t)(t + 1) * kstep;
            const char* a2 = last ? nA : cA + (size_t)(t + 2) * kstep; const char* b2 = last ? nB : cB + (size_t)(t + 2) * kstep;
            const char* a3 = a2 + kstep; const char* b3 = b2 + kstep;
            if (last && has_next) S.a_ready(nxt);
            if constexpr (SP2) {
            PG8_LDB(B0, 0, 0); PG8_LDB(B1, 0, 1); PG8_SCHED; PG8_LDA(At, 0, 0); PG8_STAGE(PG8_SA(1, 1), a1 + hstepA, voffA);
            PG8_WAIT_V(8); PG8_WAIT_L(0); PG8_BAR; PG8_MMA(0, 0, At, B0); PG8_MMA(0, 1, At, B1); PG8_BAR; PG8_SCHED;
            PG8_LDA(At, 0, 1); PG8_STAGE(PG8_SB(0, 0), b2, voffB); PG8_STAGE(PG8_SB(0, 1), b2 + hstepB, voffB); PG8_STAGE(PG8_SA(0, 0), a2, voffA);
            PG8_WAIT_V(8); PG8_WAIT_L(0); PG8_BAR; PG8_MMA(1, 0, At, B0); PG8_MMA(1, 1, At, B1); PG8_BAR; PG8_SCHED;
            PG8_LDB(B0, 1, 0); PG8_LDB(B1, 1, 1); PG8_SCHED; PG8_LDA(At, 1, 0); PG8_STAGE(PG8_SA(0, 1), a2 + hstepA, voffA);
            PG8_WAIT_V(8); PG8_WAIT_L(0); PG8_BAR; PG8_MMA(0, 0, At, B0); PG8_MMA(0, 1, At, B1); PG8_BAR; PG8_SCHED;
            PG8_LDA(At, 1, 1); PG8_STAGE(PG8_SB(1, 0), b3, voffB); PG8_STAGE(PG8_SB(1, 1), b3 + hstepB, voffB); PG8_STAGE(PG8_SA(1, 0), a3, voffA);
            PG8_WAIT_V(8); PG8_WAIT_L(0); PG8_BAR; PG8_MMA(1, 0, At, B0); PG8_MMA(1, 1, At, B1); PG8_BAR; PG8_SCHED;
            } else {
            PG8_LDB(B0, 0, 0); PG8_SCHED; PG8_LDA(At, 0, 0); PG8_STAGE(PG8_SA(1, 1), a1 + hstepA, voffA);
            PG8_WAIT_L(8); PG8_BAR; PG8_WAIT_L(0); PG8_MMA(0, 0, At, B0); PG8_BAR; PG8_SCHED;
            PG8_LDB(B1, 0, 1); PG8_STAGE(PG8_SB(0, 0), b2, voffB);
            PG8_BAR; PG8_WAIT_L(0); PG8_MMA(0, 1, At, B1); PG8_BAR;
            PG8_LDA(At, 0, 1); PG8_STAGE(PG8_SA(0, 0), a2, voffA);
            PG8_BAR; PG8_WAIT_L(0); PG8_MMA(1, 0, At, B0); PG8_BAR; PG8_SCHED;
            PG8_STAGE(PG8_SB(0, 1), b2 + hstepB, voffB);
            PG8_WAIT_V(6); PG8_BAR; PG8_MMA(1, 1, At, B1); PG8_BAR;
            PG8_LDB(B0, 1, 0); PG8_SCHED; PG8_LDA(At, 1, 0); PG8_STAGE(PG8_SA(0, 1), a2 + hstepA, voffA);
            PG8_WAIT_L(8); PG8_BAR; PG8_WAIT_L(0); PG8_MMA(0, 0, At, B0); PG8_BAR; PG8_SCHED;
            PG8_LDB(B1, 1, 1); PG8_STAGE(PG8_SB(1, 0), b3, voffB);
            PG8_BAR; PG8_WAIT_L(0); PG8_MMA(0, 1, At, B1); PG8_BAR;
            PG8_LDA(At, 1, 1); PG8_STAGE(PG8_SA(1, 0), a3, voffA);
            PG8_BAR; PG8_WAIT_L(0); PG8_MMA(1, 0, At, B0); PG8_BAR; PG8_SCHED;
            PG8_STAGE(PG8_SB(1, 1), b3 + hstepB, voffB);
            PG8_WAIT_V(6); PG8_BAR; PG8_MMA(1, 1, At, B1); PG8_BAR;
            }
        }
        if constexpr (ALIGN_EPI) { if (wr == 0) PG8_BAR; }
        if constexpr (!Epi::AFTER_DRAIN) { E(acc, cur, wr, wc, fr, fq); S.done(cur); }
        if (!has_next) break;
#pragma unroll
        for (int a = 0; a < 2; ++a)
#pragma unroll
            for (int b = 0; b < 2; ++b)
#pragma unroll
                for (int m = 0; m < 4; ++m)
#pragma unroll
                    for (int n = 0; n < 2; ++n) acc[a][b][m][n] = (f32x4){0.f, 0.f, 0.f, 0.f};
        cur = nxt; cA = nA; cB = nB; ++ui;
        if constexpr (ALIGN_EPI) { if (wr == 1) PG8_BAR; }
    }
    PG8_WAIT_V(0);
    if constexpr (!ALIGN_EPI) { if (wr == 0) PG8_BAR; }
    PG8_BAR;
    if constexpr (Epi::AFTER_DRAIN) { E.fused(acc, cur, wr, wc, fr, fq, lds, wid, lane); S.done(cur); }
#undef PG8_SA
#undef PG8_SB
#undef PG8_STAGE
#undef PG8_LDA
#undef PG8_LDB
#undef PG8_MMA
#undef PG8_WAIT_V
#undef PG8_WAIT_L
#undef PG8_BAR
#undef PG8_SCHED
}
}
template <class ASel, class Epi>
__device__ __forceinline__ void gemm_fast(const Ctx& C, const ASel& asel, int lda, const bf16_t* Bt, int ldb, int Mr, int N, int K, const Epi& epi) {
    pg8::Gemm g{Bt, lda, ldb, K}; pg8::StaticOrder S; S.init(Mr, N, (int)gridDim.x, (int)blockIdx.x);
    pg8::EpiWrap<Epi> E{epi};
    pg8::gemm_phase<pg8::EpiWrap<Epi>, ASel, pg8::StaticOrder, true, true>(C.lds, g, asel, S, E);
}
namespace att {
using s16x4  = __attribute__((ext_vector_type(4))) short;
using f32x16 = __attribute__((ext_vector_type(16))) float;
constexpr int NW = 8, QBLK = 32, KVBLK = 64;
constexpr float SCALE = 0.10206207261596577f;
constexpr float THR = 8.f;
constexpr size_t SHM_V = KVBLK * 128 * 2, SHM_K = KVBLK * 128 * 2, SHM_ATTN = 2 * SHM_V + 2 * SHM_K + NW * 64 * 4;
#define KSWZ(row, colB) ((row) * 256 + ((colB) ^ (((row) & 7) << 4)))
#define SBAR() __builtin_amdgcn_sched_barrier(0)
__device__ __forceinline__ int crow(int r, int hi) { return (r & 3) + 8 * (r >> 2) + 4 * hi; }
__device__ __forceinline__ unsigned cvtpk(float lo, float hi) { unsigned r; asm volatile("v_cvt_pk_bf16_f32 %0, %1, %2" : "=v"(r) : "v"(lo), "v"(hi)); return r; }

__device__ __forceinline__ void partialSM(f32x16& p0, f32x16& p1, float& m_reg, float& mn, float& alpha) {
  constexpr float C = SCALE * 1.4426950408889634f;
  float pmax = p0[0];
#pragma unroll
  for (int r = 1; r < 16; ++r) pmax = fmaxf(pmax, p0[r]);
#pragma unroll
  for (int r = 0; r < 16; ++r) pmax = fmaxf(pmax, p1[r]);
  { auto rr = __builtin_amdgcn_permlane32_swap(__float_as_uint(pmax), __float_as_uint(pmax), false, false);
    pmax = fmaxf(__uint_as_float(rr[0]), __uint_as_float(rr[1])); }
  if (__builtin_expect(__all(pmax - m_reg <= THR / SCALE), 1)) { mn = m_reg; alpha = 1.f; }
  else { mn = fmaxf(m_reg, pmax); alpha = __builtin_amdgcn_exp2f((m_reg - mn) * C); m_reg = mn; }
  float mnC = -mn * C;
#pragma unroll
  for (int r = 0; r < 16; ++r) p0[r] = fmaf(p0[r], C, mnC);
#pragma unroll
  for (int r = 0; r < 16; ++r) p1[r] = fmaf(p1[r], C, mnC);
#pragma unroll
  for (int r = 0; r < 16; ++r) p0[r] = __builtin_amdgcn_exp2f(p0[r]);
}
__device__ __forceinline__ void finishSM(f32x16& p0, f32x16& p1, float alpha, float& l_reg, bf16x8& pa0, bf16x8& pa1, bf16x8& pa2, bf16x8& pa3) {
#pragma unroll
  for (int r = 0; r < 16; ++r) p1[r] = __builtin_amdgcn_exp2f(p1[r]);
  float ps = 0;
#pragma unroll
  for (int r = 0; r < 16; ++r) ps += p0[r];
#pragma unroll
  for (int r = 0; r < 16; ++r) ps += p1[r];
  { auto rr = __builtin_amdgcn_permlane32_swap(__float_as_uint(ps), __float_as_uint(ps), false, false);
    ps = __uint_as_float(rr[0]) + __uint_as_float(rr[1]); }
  l_reg = l_reg * alpha + ps;
#define PK4(P, BASE, OUT) do { unsigned a0 = cvtpk(P[BASE + 0], P[BASE + 1]), a1 = cvtpk(P[BASE + 2], P[BASE + 3]);   \
    unsigned b0 = cvtpk(P[BASE + 4], P[BASE + 5]), b1 = cvtpk(P[BASE + 6], P[BASE + 7]);                              \
    auto r0 = __builtin_amdgcn_permlane32_swap(a0, b0, false, false); auto r1 = __builtin_amdgcn_permlane32_swap(a1, b1, false, false); \
    u32x4 w = {r0[0], r1[0], r0[1], r1[1]}; OUT = *reinterpret_cast<bf16x8*>(&w); } while (0)
  PK4(p0, 0, pa0); PK4(p0, 8, pa1); PK4(p1, 0, pa2); PK4(p1, 8, pa3);
#undef PK4
}
__device__ __forceinline__ void qkt(f32x16& p0, f32x16& p1, const char* Ks, const bf16x8* qr, int r32, int hi) {
  p0 = f32x16{}; p1 = f32x16{};
#pragma unroll
  for (int d0 = 0; d0 < 6; ++d0) { int cb = (d0 * 16 + hi * 8) * 2;
    bf16x8 b0 = *reinterpret_cast<const bf16x8*>(Ks + KSWZ(r32, cb));
    bf16x8 b1 = *reinterpret_cast<const bf16x8*>(Ks + KSWZ(32 + r32, cb));
    p0 = __builtin_amdgcn_mfma_f32_32x32x16_bf16(b0, qr[d0], p0, 0, 0, 0);
    p1 = __builtin_amdgcn_mfma_f32_32x32x16_bf16(b1, qr[d0], p1, 0, 0, 0); }
}
__device__ __forceinline__ int v_st(int k, int c) { const int kk = (k & ~0xC) | ((k & 4) << 1) | ((k & 8) >> 1); return ((kk >> 3) * 4 + (c >> 5)) * 512 + ((kk & 7) * 32 + (c & 31)) * 2; }
__device__ __forceinline__ int v_rd_base(int lane) { return ((lane & 3) << 3) | (((lane >> 2) & 3) << 6) | (((lane >> 4) & 1) << 5) | (((lane >> 5) & 1) << 8); }
constexpr int v_rd_off(int d0, int ks, int half) { return d0 * 512 + ks * 4096 + half * 2048; }
template <int OFF> __device__ __forceinline__ s16x4 tr_read(int vb) {
  s16x4 r; asm volatile("ds_read_b64_tr_b16 %0, %1 offset:%2" : "=&v"(r) : "v"(vb), "i"(OFF) : "memory"); return r;
}
template <int D0> __device__ __forceinline__ void pv_one(f32x16& od, int vb, bf16x8 pa0, bf16x8 pa1, bf16x8 pa2, bf16x8 pa3) {
  const s16x4 l0 = tr_read<v_rd_off(D0, 0, 0)>(vb), h0 = tr_read<v_rd_off(D0, 0, 1)>(vb), l1 = tr_read<v_rd_off(D0, 1, 0)>(vb), h1 = tr_read<v_rd_off(D0, 1, 1)>(vb);
  const s16x4 l2 = tr_read<v_rd_off(D0, 2, 0)>(vb), h2 = tr_read<v_rd_off(D0, 2, 1)>(vb), l3 = tr_read<v_rd_off(D0, 3, 0)>(vb), h3 = tr_read<v_rd_off(D0, 3, 1)>(vb);
  asm volatile("s_waitcnt lgkmcnt(0)" ::: "memory"); SBAR();
#define PK(L, H) (bf16x8){L[0], L[1], L[2], L[3], H[0], H[1], H[2], H[3]}
  od = __builtin_amdgcn_mfma_f32_32x32x16_bf16(pa0, PK(l0, h0), od, 0, 0, 0);
  od = __builtin_amdgcn_mfma_f32_32x32x16_bf16(pa1, PK(l1, h1), od, 0, 0, 0);
  od = __builtin_amdgcn_mfma_f32_32x32x16_bf16(pa2, PK(l2, h2), od, 0, 0, 0);
  od = __builtin_amdgcn_mfma_f32_32x32x16_bf16(pa3, PK(l3, h3), od, 0, 0, 0);
#undef PK
}
__device__ __forceinline__ void pv_d0(f32x16* o, int vb, bf16x8 pa0, bf16x8 pa1, bf16x8 pa2, bf16x8 pa3) {
  pv_one<0>(o[0], vb, pa0, pa1, pa2, pa3); pv_one<1>(o[1], vb, pa0, pa1, pa2, pa3);
}

__device__ __forceinline__ void attn_unit(const bf16_t* __restrict__ Q, const bf16_t* __restrict__ KVm, const bf16_t* __restrict__ KPEm, bf16_t* __restrict__ O, const float* __restrict__ ROPE,
                                          int q0row, int k0row, int seq, int h, int rope_t0, char* lds) {
  const int tid = threadIdx.x, wid = tid >> 6, lane = tid & 63, r32 = lane & 31, hi = lane >> 5;
  char* V_lds = lds; char* K_lds = lds + 2 * SHM_V;
  float* ws = (float*)(lds + 2 * SHM_V + 2 * SHM_K) + wid * 64; float* li_l = ws; float* al_l = ws + 32;
  float m_reg = -1e30f, l_reg = 0; f32x16 o[2] = {}; bf16x8 qr[6];
  { const bf16_t* Qw = Q + (size_t)(q0row + wid * QBLK + r32) * 1536 + h * 96 + hi * 8;
#pragma unroll
    for (int d0 = 0; d0 < 6; ++d0) qr[d0] = *reinterpret_cast<const bf16x8*>(Qw + d0 * 16);
    if (rope_t0 >= 0) { const int t = rope_t0 + wid * QBLK + r32;
#pragma unroll
      for (int ax = 0; ax < 2; ++ax) { const int pos = ax == 0 ? (t >> 6) : (t & 63); u32x4 w = *reinterpret_cast<u32x4*>(&qr[4 + ax]); unsigned wv[4] = {w.x, w.y, w.z, w.w};
#pragma unroll
        for (int j = 0; j < 4; ++j) { const int f = 4 * hi + j; const float c = ROPE[pos * 8 + f], sn = ROPE[512 + pos * 8 + f]; const float x1 = bflo(wv[j]), x2 = bfhi(wv[j]);
          wv[j] = pk2(x1 * c - x2 * sn, x1 * sn + x2 * c); }
        w = (u32x4){wv[0], wv[1], wv[2], wv[3]}; qr[4 + ax] = *reinterpret_cast<bf16x8*>(&w); } } }
  const int sr = tid >> 4, sc = (tid & 15) * 8, vst0 = v_st(sr, sc), vst1 = v_st(32 + sr, sc);
  const int vb0 = (int)(uintptr_t)V_lds + v_rd_base(lane);
  const bf16_t* kp0; size_t kstride;
  if (sc < 64) { kp0 = KVm + (size_t)k0row * 2048 + h * 128 + sc; kstride = 2048; } else { kp0 = KPEm + (size_t)k0row * 32 + ((sc - 64) & 31); kstride = 32; }
  const bf16_t* vp0 = KVm + (size_t)k0row * 2048 + h * 128 + 64 + (sc & 63);
  struct { bf16x8 vs0, vs1, ks0, ks1; } sr_[2];
#define SLOAD(i, k0) do { sr_[i].vs0 = *(const bf16x8*)(vp0 + (size_t)((k0) + sr) * 2048); sr_[i].vs1 = *(const bf16x8*)(vp0 + (size_t)((k0) + 32 + sr) * 2048); \
    sr_[i].ks0 = *(const bf16x8*)(kp0 + (size_t)((k0) + sr) * kstride); sr_[i].ks1 = *(const bf16x8*)(kp0 + (size_t)((k0) + 32 + sr) * kstride); } while (0)
#define SWRITE(b, i) do { *(bf16x8*)(V_lds + (b) * SHM_V + vst0) = sr_[i].vs0; *(bf16x8*)(V_lds + (b) * SHM_V + vst1) = sr_[i].vs1; int kc = sc * 2; \
    *(bf16x8*)(K_lds + (b) * SHM_K + KSWZ(sr, kc)) = sr_[i].ks0; *(bf16x8*)(K_lds + (b) * SHM_K + KSWZ(32 + sr, kc)) = sr_[i].ks1; } while (0)
#define SWAIT() asm volatile("s_waitcnt vmcnt(4)" ::: "memory")
#define RESC(a) do { if (__any((a) < 1.f)) { if (hi == 0) al_l[r32] = (a); asm volatile("s_waitcnt lgkmcnt(0)" ::: "memory"); \
    _Pragma("unroll") for (int d = 0; d < 2; ++d) _Pragma("unroll") for (int r = 0; r < 16; ++r) o[d][r] *= al_l[crow(r, hi)]; } } while (0)
  f32x16 pA0, pA1, pB0, pB1; float mnA, mnB, alA, alB; bf16x8 pa0, pa1, pa2, pa3; const int NT = seq / KVBLK;
  constexpr int SE = 0, SO = 1;
  SLOAD(SE, 0); asm volatile("s_waitcnt vmcnt(0)" ::: "memory"); SWRITE(0, SE); __syncthreads();
  qkt(pA0, pA1, K_lds, qr, r32, hi); partialSM(pA0, pA1, m_reg, mnA, alA);
  SLOAD(SO, KVBLK); if (2 < NT) SLOAD(SE, 2 * KVBLK);
  SWAIT(); SWRITE(1, SO); __syncthreads();
  for (int j = 1; j + 1 < NT; j += 2) {
    SBAR(); qkt(pB0, pB1, K_lds + SHM_K, qr, r32, hi);
    finishSM(pA0, pA1, alA, l_reg, pa0, pa1, pa2, pa3); SBAR();
    SLOAD(SO, (j + 2) * KVBLK); SBAR();
    pv_d0(o, vb0, pa0, pa1, pa2, pa3); partialSM(pB0, pB1, m_reg, mnB, alB);
    __syncthreads(); SWAIT(); SWRITE(0, SE);
    RESC(alB); __syncthreads();
    SBAR(); qkt(pA0, pA1, K_lds, qr, r32, hi);
    finishSM(pB0, pB1, alB, l_reg, pa0, pa1, pa2, pa3); SBAR();
    if (j + 3 < NT) SLOAD(SE, (j + 3) * KVBLK); SBAR();
    pv_d0(o, vb0 + (int)SHM_V, pa0, pa1, pa2, pa3); partialSM(pA0, pA1, m_reg, mnA, alA);
    __syncthreads(); SWAIT(); SWRITE(1, SO);
    RESC(alA); __syncthreads();
  }
  SBAR(); qkt(pB0, pB1, K_lds + SHM_K, qr, r32, hi);
  finishSM(pA0, pA1, alA, l_reg, pa0, pa1, pa2, pa3); SBAR();
  pv_d0(o, vb0, pa0, pa1, pa2, pa3); partialSM(pB0, pB1, m_reg, mnB, alB);
  __syncthreads(); RESC(alB);
  finishSM(pB0, pB1, alB, l_reg, pa0, pa1, pa2, pa3); SBAR();
  pv_d0(o, vb0 + (int)SHM_V, pa0, pa1, pa2, pa3);
  if (hi == 0) li_l[r32] = l_reg; asm volatile("s_waitcnt lgkmcnt(0)" ::: "memory");
  float rli[16];
#pragma unroll
  for (int r = 0; r < 16; ++r) rli[r] = __builtin_amdgcn_rcpf(li_l[crow(r, hi)]);
  bf16_t* Ow = O + (size_t)(q0row + wid * QBLK) * 1024 + h * 64;
#pragma unroll
  for (int r = 0; r < 16; ++r) { const int orow = crow(r, hi);
#pragma unroll
    for (int d0 = 0; d0 < 2; ++d0) Ow[(size_t)orow * 1024 + d0 * 32 + r32] = (bf16_t)f2bf(o[d0][r] * rli[r]); }
  asm volatile("s_waitcnt vmcnt(0)" ::: "memory");
  __syncthreads();
#undef SLOAD
#undef SWRITE
#undef SWAIT
#undef RESC
}
#undef KSWZ
#undef SBAR
}

__device__ __forceinline__ void phase_attn_fast(const Ctx& C) {
    unsigned char* ws = C.a->ws; const bf16_t* Q = (const bf16_t*)(ws + WS_SCR + S_Q); const bf16_t* KV = (const bf16_t*)(ws + WS_SCR + S_KV);
    const bf16_t* KPE = (const bf16_t*)(ws + WS_SCR + S_KPE); bf16_t* O = (bf16_t*)(ws + WS_SCR + S_O); const float* ROPE = (const float*)(ws + WS_ROPE);
    char* lds = (char*)(unsigned char*)C.lds;
    const int bx = blockIdx.x, G = gridDim.x; const int vcu = (G % 8 == 0) ? (bx % 8) * (G / 8) + bx / 8 : bx;
    for (int u = vcu; u < 1024; u += G) {
        int q0, k0, seq, h, rt;
        if (u < 512) { const int bh = u >> 4, qb = u & 15, b = bh >> 4; h = bh & 15; q0 = NPR + b * 4096 + qb * 256; k0 = NPR + b * 4608; seq = 4608; rt = qb * 256; }
        else { const int v = u - 512, b = v >> 4; h = v & 15; q0 = b * 256; k0 = b * 256; seq = 256; rt = -1; }
        att::attn_unit(Q, KV, KPE, O, ROPE, q0, k0, seq, h, rt, lds);
    }
}
#ifndef MK_MULTI
#define MK_MULTI 0
#endif
constexpr int NPHASES = 38;

__global__ void __launch_bounds__(NWAVES * 64, 2) mega_fwd(Args args) {
    extern __shared__ __attribute__((aligned(16))) unsigned char lds_raw[];
    Ctx C; C.a = &args; C.lds = (LAS unsigned char*)lds_raw;
    C.tid = threadIdx.x; C.lane = C.tid & 63; C.wave = __builtin_amdgcn_readfirstlane(C.tid >> 6);
    C.gw = blockIdx.x * NWAVES + C.wave; C.NGW = gridDim.x * NWAVES;
    volatile LAS unsigned* MISC = (volatile LAS unsigned*)(C.lds + MISC_OFF);
    if (C.tid < 32) MISC[C.tid] = 0u;
    __syncthreads();
    unsigned char* ws = args.ws;
    unsigned* ctl = (unsigned*)(ws + WS_CTL);
    XcdBarrier bar; bar.bar = ctl + CW_BAR; bar.x = 0; bar.st = MISC + 8;
    if (!MK_MULTI) bar = xcd_barrier_post(ctl + CW_BAR, MISC + 8);
    const int lo = args.ph_lo, hi = args.ph_hi; int ph = 0;
#ifndef DUP_PHASE
#define DUP_PHASE -1
#endif
#define PHASE(body) do { if (ph >= lo && ph < hi) { if (ph == DUP_PHASE) { body; xcd_barrier(bar); } body; if (!MK_MULTI && ph + 1 < hi) xcd_barrier(bar); else __syncthreads(); } ++ph; } while (0)

    bf16_t* WB = (bf16_t*)(ws + WS_W); float* X = (float*)(ws + WS_X); const bf16_t* H = (const bf16_t*)(ws + WS_H); const float* MOD = (const float*)(ws + WS_MOD);
    PHASE(phase0(C));
    PHASE(phase_init(C));
#define DO_LAYER(layer) do { \
        const int kind = layer % 3, j = layer / 3; \
        if (kind == 0) { \
            unsigned char* wm = (unsigned char*)WB + W_MLA + j * W_MLA_STRIDE; \
            PHASE(gemm_fast(C, ASelPlain{H}, 1024, (const bf16_t*)(wm + W_MLA_1), 1024, MROWS, 768, 1024, EpiF32{(float*)(ws + WS_SCR + S_R1), 768})); \
            PHASE(phase_mla_norm(C, j)); \
            PHASE(gemm_fast(C, ASelPlain{(const bf16_t*)(ws + WS_SCR + S_QA)}, 384, (const bf16_t*)(wm + W_MLA_QB), 384, MROWS, 1536, 384, EpiBf16{(bf16_t*)(ws + WS_SCR + S_Q), 1536}); \
                  gemm_fast(C, ASelPlain{(const bf16_t*)(ws + WS_SCR + S_CKV)}, 256, (const bf16_t*)(wm + W_MLA_KVB), 256, KVR, 2048, 256, EpiBf16{(bf16_t*)(ws + WS_SCR + S_KV), 2048})); \
            PHASE(phase_attn_fast(C)); \
            PHASE(gemm_fast(C, ASelPlain{(const bf16_t*)(ws + WS_SCR + S_O)}, 1024, (const bf16_t*)(wm + W_MLA_O), 1024, MROWS, 1024, 1024, EpiResid{X, MOD, layer, 2, nullptr})); \
        } else if (kind == 1) { \
            unsigned char* wr = (unsigned char*)WB + W_RW; const bf16_t* XA = (const bf16_t*)(ws + WS_H + R_XA); \
            PHASE(phase_rw_prep(C, layer, 0)); \
            PHASE(gemm_fast(C, ASelShift{XA, 10, (size_t)MROWS * DM}, 1024, (const bf16_t*)(wr + W_RW_1), 1024, MROWS, 3072, 1024, EpiRwA{(bf16_t*)(ws + WS_H + R_R)})); \
            PHASE(phase_rw_prep(C, layer, 1)); \
            PHASE(gemm_fast(C, ASelShift{XA, 8, (size_t)MROWS * DM}, 1024, (const bf16_t*)(wr + W_RW_1) + (size_t)3072 * 1024, 1024, MROWS, 768, 1024, EpiRwB{(bf16_t*)(ws + WS_H + R_T2), (bf16_t*)(ws + WS_H + R_SG)})); \
            PHASE(phase_rw_scan_seq(C)); \
            PHASE(gemm_fast(C, ASelPlain{(const bf16_t*)(ws + WS_H + R_SG)}, 256, (const bf16_t*)(wr + W_RW_G2T), 256, MROWS, 1024, 256, EpiBf16{(bf16_t*)(ws + WS_H + R_G), 1024})); \
            PHASE(phase_rw_post(C)); \
            PHASE(gemm_fast(C, ASelPlain{(const bf16_t*)(ws + WS_H + R_Y)}, 1024, (const bf16_t*)(wr + W_RW_O), 1024, MROWS, 1024, 1024, EpiResid{X, MOD, layer, 2, nullptr})); \
        } else { \
            PHASE(phase_pool_prep(C, layer)); \
            PHASE(gemm_fast(C, ASelShift{(const bf16_t*)(ws + WS_SCR + S_POOL), 8, (size_t)256}, 1024, (const bf16_t*)((unsigned char*)WB + W_POOL), 256, MROWS, 1024, 256, EpiResid{X, MOD, layer, 2, args.in[I_POOLS]})); \
        } \
        PHASE(phase_ln(C, layer, 0, layer, 3, false)); \
        PHASE(gemm_fast(C, ASelPlain{H}, 1024, (const bf16_t*)((unsigned char*)WB + layer * W_FFN_STRIDE + W_FFN_GU), 1024, MROWS, 5632, 1024, EpiSwiglu{(bf16_t*)(ws + WS_SCR + S_ACT)})); \
        PHASE(gemm_fast(C, ASelPlain{(const bf16_t*)(ws + WS_SCR + S_ACT)}, 2816, (const bf16_t*)((unsigned char*)WB + layer * W_FFN_STRIDE + W_FFN_D), 2816, MROWS, 1024, 2816, EpiResid{X, MOD, layer, 5, nullptr})); \
        PHASE(phase_ln(C, layer, 1, layer + 1, (layer == 2) ? 0 : -1, layer == 3)); \
     \
} while (0)
    DO_LAYER(0); DO_LAYER(1); DO_LAYER(2); DO_LAYER(3);
    if (!MK_MULTI && xb_ld(ctl + CW_BAR + XB_TMO) != 0u && blockIdx.x == 0 && C.tid == 0) args.out[0] = __builtin_nanf("");
}

extern "C" void kernel_launch(void* const* d_in, const int* in_sizes, int n_in, void* d_out, int out_size, void* d_ws, size_t ws_size, hipStream_t stream) {
    static int grid = 0;
    if (grid == 0) {
        int dev = 0, cus = 0, per_cu = 0;
        if (hipGetDevice(&dev) != hipSuccess || hipDeviceGetAttribute(&cus, hipDeviceAttributeMultiprocessorCount, dev) != hipSuccess) grid = -1;
        else if (hipFuncSetAttribute((const void*)mega_fwd, hipFuncAttributeMaxDynamicSharedMemorySize, LDS_BYTES) != hipSuccess) grid = -1;
        else {
            if (hipOccupancyMaxActiveBlocksPerMultiprocessor(&per_cu, (const void*)mega_fwd, NWAVES * 64, LDS_BYTES) != hipSuccess || per_cu < 1) { fprintf(stderr, "occupancy query: %d\n", per_cu); grid = -1; }
            else grid = cus;
            (void)hipGetLastError();
        }
        if (n_in != 41 || out_size != OUT_TOTAL || ws_size < WS_END) { fprintf(stderr, "kernel_launch: unexpected n_in %d out %d ws %zu\n", n_in, out_size, ws_size); grid = -2; }
    }
    if (grid == -2) { (void)hipMemsetAsync(d_out, 0xFF, (size_t)out_size * 4, stream); return; }
    if (grid < 0) return;
    (void)hipMemsetAsync((char*)d_ws + WS_CTL, 0, CTL_ZERO_BYTES, stream);
    Args a{};
    for (int i = 0; i < 41; ++i) a.in[i] = (const float*)d_in[i];
    a.out = (float*)d_out; a.ws = (unsigned char*)d_ws;
#if MK_MULTI
    for (int p = 0; p < NPHASES; ++p) { a.ph_lo = p; a.ph_hi = p + 1; hipLaunchKernelGGL(mega_fwd, dim3(grid), dim3(NWAVES * 64), LDS_BYTES, stream, a); }
#else
    a.ph_lo = 0; a.ph_hi = NPHASES;
    void* kargs[] = {&a};
    hipError_t e = hipLaunchCooperativeKernel((const void*)mega_fwd, dim3(grid), dim3(NWAVES * 64), kargs, LDS_BYTES, stream);
    if (e != hipSuccess) fprintf(stderr, "cooperative launch failed: %s (grid %d)\n", hipGetErrorString(e), grid);
#endif
}
```

```cpp
#include <hip/hip_runtime.h>
#include <cstdio>
#include <cstdint>

#define GAS __attribute__((address_space(1)))
#define LAS __attribute__((address_space(3)))
typedef unsigned short bf16_t;
typedef float f32x4 __attribute__((ext_vector_type(4)));
typedef float f32x2 __attribute__((ext_vector_type(2)));
typedef unsigned u32x4 __attribute__((ext_vector_type(4)));
typedef unsigned u32x2 __attribute__((ext_vector_type(2)));
typedef short bf16x8 __attribute__((ext_vector_type(8)));

constexpr int DM = 1024, NPR = 8192, MROWS = 16384, DFF = 2816, NHEAD = 16;
constexpr int KVR = 17408;
constexpr float ALPHA = 1.681792830507429f;
constexpr int OUT_YP = 0, OUT_YS = 8388608, OUT_CKV = 16777216, OUT_KPE = 20971520, OUT_WKV = 21495808, OUT_TOTAL = 25690112;

constexpr size_t MiB = 1u << 20;
constexpr size_t WS_CTL = 0, CTL_ZERO_BYTES = 1 * MiB;
constexpr size_t WS_MOD = 1 * MiB;
constexpr size_t WS_ROPE = WS_MOD + 512 * 1024;
constexpr size_t WS_BON = WS_MOD + 576 * 1024;
constexpr size_t WS_W = 2 * MiB;
constexpr size_t W_FFN_GU = 0, W_FFN_D = 11 * MiB, W_FFN_STRIDE = 16 * MiB + 512 * 1024;
constexpr size_t W_MLA = 66 * MiB, W_MLA_STRIDE = 6 * MiB;
constexpr size_t W_MLA_1 = 0, W_MLA_QB = 1536 * 1024, W_MLA_KVB = 1536 * 1024 + 1152 * 1024, W_MLA_O = 1536 * 1024 + 1152 * 1024 + 1024 * 1024;
constexpr size_t W_RW = 78 * MiB;
constexpr size_t W_RW_1 = 0, W_RW_G2T = 7 * MiB + 512 * 1024, W_RW_O = 8 * MiB, W_RW_W2T = 10 * MiB, W_RW_A2T = 10 * MiB + 256 * 1024;
constexpr size_t W_POOL = 91 * MiB;
constexpr size_t WS_X = 94 * MiB;
constexpr size_t WS_H = 158 * MiB;
constexpr size_t WS_SCR = 190 * MiB;
constexpr size_t WS_END = 384 * MiB;
constexpr size_t S_R1 = 0, S_Q = 0, S_KV = 48 * MiB, S_O = 116 * MiB, S_QA = 148 * MiB, S_CKV = 160 * MiB, S_KPE = 169 * MiB;
constexpr size_t S_ACT = 0;
constexpr size_t S_POOL = 0;
constexpr size_t R_XA = 0, R_R = 96 * MiB, R_K = 128 * MiB, R_V = 160 * MiB, R_T2 = 192 * MiB, R_SG = 200 * MiB, R_Y = 0, R_QT = 64 * MiB, R_EP = 208 * MiB, R_BON = 224 * MiB, R_G = 96 * MiB, R_SS = 128 * MiB;

constexpr int NWAVES = 8;
constexpr int LDS_BYTES = 147456;
constexpr int MISC_OFF = LDS_BYTES - 128;
constexpr int CW_BAR = 4096;

__device__ __forceinline__ unsigned f2bf(float f) { unsigned u = __builtin_bit_cast(unsigned, f); return (u + 0x7fffu + ((u >> 16) & 1u)) >> 16; }
typedef __bf16 bf16x2_t __attribute__((ext_vector_type(2)));
__device__ __forceinline__ unsigned pk2(float lo, float hi) { const f32x2 v = {lo, hi}; const bf16x2_t b = __builtin_convertvector(v, bf16x2_t); return __builtin_bit_cast(unsigned, b); }
__device__ __forceinline__ float bf2f(unsigned short b) { return __builtin_bit_cast(float, (unsigned)b << 16); }
__device__ __forceinline__ float bflo(unsigned w) { return __builtin_bit_cast(float, w << 16); }
__device__ __forceinline__ float bfhi(unsigned w) { return __builtin_bit_cast(float, w & 0xffff0000u); }
__device__ __forceinline__ float wave_sum(float v) {
#pragma unroll
    for (int o = 1; o < 64; o <<= 1) v += __shfl_xor(v, o);
    return v;
}
__device__ __forceinline__ float wave_max(float v) {
#pragma unroll
    for (int o = 1; o < 64; o <<= 1) v = fmaxf(v, __shfl_xor(v, o));
    return v;
}
__device__ __forceinline__ float sigmoidf_(float x) { return 1.0f / (1.0f + __expf(-x)); }
__device__ __forceinline__ float siluf_(float x) { return x / (1.0f + __expf(-x)); }
__device__ __forceinline__ int cond_of_row(int row) { return row < NPR ? 0 : 1 + ((row - NPR) >> 12); }
__device__ __forceinline__ const float* modp(const float* MOD, int layer, int cond, int j) { return MOD + (size_t)((layer * 3 + cond) * 6 + j) * DM; }
__device__ __forceinline__ int perm32(int rho) { const int n = rho >> 4, i = rho & 15; return 8 * (i >> 2) + 4 * n + (i & 3); }

#define XB_TMO      128
#define XB_XCNT(j)  (256  + 64 * (j))
#define XB_XSUB(j)  (1280 + 64 * (j))
#define XB_XGEN(j)  (2304 + 64 * (j))
#define XB_TOP      3328
#define XB_TOPGEN   3392
#define XCD_BAR_WORDS 3456
#define XB_SPIN_CAP (1u << 18)
__device__ __forceinline__ unsigned xb_ld(unsigned* p)              { return __hip_atomic_load(p, __ATOMIC_RELAXED, __HIP_MEMORY_SCOPE_AGENT); }
__device__ __forceinline__ unsigned xb_add(unsigned* p, unsigned v) { return __hip_atomic_fetch_add(p, v, __ATOMIC_RELAXED, __HIP_MEMORY_SCOPE_AGENT); }
__device__ __forceinline__ unsigned xb_xcc_id() { return (unsigned)__builtin_amdgcn_s_getreg((3 << 11) | 20) & 0xFu; }
#define XB_SPIN(cond, bar) do { unsigned _sp = 0; while (cond) { __builtin_amdgcn_s_sleep(1); \
    if ((++_sp & 255u) == 0u) { if (xb_ld(&(bar)[XB_TMO])) break; if (_sp > XB_SPIN_CAP) { atomicAdd(&(bar)[XB_TMO], 1u); break; } } } } while (0)
struct XcdBarrier { unsigned* bar; unsigned x; volatile LAS unsigned* st; };
__device__ __forceinline__ XcdBarrier xcd_barrier_post(unsigned* bar, volatile LAS unsigned* st) {
    XcdBarrier b; b.bar = bar; b.x = xb_xcc_id(); b.st = st;
    if (threadIdx.x == 0) (void)xb_add(&bar[XB_XCNT(b.x)], 1u);
    return b;
}
__device__ __forceinline__ void xcd_barrier_complete(unsigned* bar, unsigned x, unsigned& nloc, unsigned& nx) {
    const unsigned G = gridDim.x * gridDim.y * gridDim.z;
    unsigned sum, cnt, mine, sp = 0u;
    for (;;) {
        sum = 0u; cnt = 0u; mine = 0u;
#pragma unroll
        for (unsigned j = 0; j < 16; ++j) { const unsigned c = xb_ld(&bar[XB_XCNT(j)]); sum += c; cnt += (c > 0u) ? 1u : 0u; mine = (j == x) ? c : mine; }
        if (sum == G) break;
        __builtin_amdgcn_s_sleep(1);
        if ((++sp & 255u) == 0u) { if (xb_ld(&bar[XB_TMO])) break; if (sp > XB_SPIN_CAP) { atomicAdd(&bar[XB_TMO], 1u); break; } }
    }
    nloc = mine > 0u ? mine : 1u; nx = cnt > 0u ? cnt : 1u;
}
__device__ __forceinline__ void xcd_barrier(const XcdBarrier& b) {
    asm volatile("s_waitcnt vmcnt(0)" ::: "memory");
    __syncthreads();
    if (threadIdx.x == 0) {
        unsigned* bar = b.bar;
        __builtin_amdgcn_s_waitcnt(0);
        unsigned nloc = b.st[0], nx = b.st[1];
        if (nloc == 0u) { xcd_barrier_complete(bar, b.x, nloc, nx); b.st[0] = nloc; b.st[1] = nx; }
        const unsigned old = xb_add(&bar[XB_XSUB(b.x)], 1u);
        const unsigned gen = old / nloc;
        if (old + 1u == (gen + 1u) * nloc) {
            __builtin_amdgcn_fence(__ATOMIC_RELEASE, "agent");
            asm volatile("s_waitcnt vmcnt(0)" ::: "memory");
            const unsigned og = xb_add(&bar[XB_TOP], 1u);
            const unsigned tg = og / nx;
            if (og + 1u == (tg + 1u) * nx) xb_add(&bar[XB_TOPGEN], 1u);
            else XB_SPIN(xb_ld(&bar[XB_TOPGEN]) == tg, bar);
            __builtin_amdgcn_fence(__ATOMIC_ACQUIRE, "agent");
            xb_add(&bar[XB_XGEN(b.x)], 1u);
            asm volatile("s_waitcnt vmcnt(0)" ::: "memory");
        } else {
            XB_SPIN(xb_ld(&bar[XB_XGEN(b.x)]) == gen, bar);
            __builtin_amdgcn_fence(__ATOMIC_ACQUIRE, "agent");
            asm volatile("s_waitcnt vmcnt(0)" ::: "memory");
        }
    }
    __syncthreads();
}
struct Args { const float* in[41]; float* out; unsigned char* ws; int ph_lo, ph_hi; };
enum { I_XP = 0, I_XS, I_CCKV, I_CKPE, I_SWKV, I_C, I_CCTX, I_ADAW, I_ADAB, I_LNG, I_LNB, I_WG, I_WU, I_WD, I_WQA, I_QNORM, I_WQB, I_WKVA, I_KVNORM, I_WKVB, I_MWO,
       I_MU, I_WR, I_WK, I_WV, I_W0, I_W1, I_W2, I_A0, I_A1, I_A2, I_G1, I_G2, I_KK, I_KA, I_RK, I_LNXG, I_LNXB, I_RWO, I_POOLW, I_POOLS };

struct Ctx {
    const Args* a;
    LAS unsigned char* lds;
    int tid, lane, wave, gw, NGW;
};

enum { MAP_ID = 0, MAP_GU = 1, MAP_QB = 2, MAP_KVA = 3 };
__device__ __forceinline__ int map_row(int map, int mp, int n) {
    if (map == MAP_ID) return mp + n;
    if (map == MAP_GU) return (n >> 2) * 8 + mp * 4 + (n & 3);
    if (map == MAP_QB) { const int h = n / 96, d = n - h * 96; if (d < 64) return n; const int i = d - 64; return h * 96 + 64 + (i & 16) + ((i & 7) << 1) + ((i >> 3) & 1); }
           { if (n < 256) return 384 + n; const int i = n - 256; return 640 + (i & 16) + ((i & 7) << 1) + ((i >> 3) & 1); }
}
__device__ __forceinline__ void conv_tile(const float* W, int ldw, int nblk, int tile, bf16_t* WT, int ldk, int koff, int map, int mp, LAS float* scr, int lane) {
    const int kb = tile / nblk, nb = tile - kb * nblk, k0 = 64 * kb, n0 = 32 * nb;
#pragma unroll 8
    for (int i = 0; i < 32; ++i) { const int kk = 2 * i + (lane >> 5); scr[kk * 33 + (lane & 31)] = W[(size_t)(k0 + kk) * ldw + n0 + (lane & 31)]; }
    asm volatile("s_waitcnt lgkmcnt(0)" ::: "memory");
    const int c = lane & 7;
#pragma unroll
    for (int j = 0; j < 4; ++j) { const int n = (lane >> 3) + 8 * j; const LAS float* s = scr + (8 * c) * 33 + n;
        u32x4 o; o.x = pk2(s[0 * 33], s[1 * 33]); o.y = pk2(s[2 * 33], s[3 * 33]); o.z = pk2(s[4 * 33], s[5 * 33]); o.w = pk2(s[6 * 33], s[7 * 33]);
        *(u32x4*)(WT + (size_t)map_row(map, mp, n0 + n) * ldk + koff + k0 + 8 * c) = o; }
    asm volatile("s_waitcnt lgkmcnt(0)" ::: "memory");
}
__device__ __forceinline__ void zero_rect_item(bf16_t* Wt, int ld, int r0, int c0, int nc, int item, int lane) {
    const int cpr = nc >> 3; const int idx = item * 64 + lane; const int r = idx / cpr, c = idx - r * cpr;
    *(u32x4*)(Wt + (size_t)(r0 + r) * ld + c0 + 8 * c) = (u32x4){0u, 0u, 0u, 0u};
}
__device__ __forceinline__ void adaln_item(const Ctx& C, int item, float* MOD) {
    const int layer = item / 96, cg = item - layer * 96, col = cg * 64 + C.lane;
    const float* W = C.a->in[I_ADAW] + (size_t)layer * DM * 6144 + col;
    const float* cx = C.a->in[I_CCTX]; const float* c0 = C.a->in[I_C]; const float* c1 = c0 + DM;
    float a0 = 0.f, a1 = 0.f, a2 = 0.f;
    for (int kb = 0; kb < DM; kb += 64) {
        const float s0 = siluf_(cx[kb + C.lane]), s1 = siluf_(c0[kb + C.lane]), s2 = siluf_(c1[kb + C.lane]);
#pragma unroll
        for (int kk = 0; kk < 64; ++kk) {
            const float w = W[(size_t)(kb + kk) * 6144];
            a0 = fmaf(__builtin_bit_cast(float, __builtin_amdgcn_readlane(__builtin_bit_cast(int, s0), kk)), w, a0);
            a1 = fmaf(__builtin_bit_cast(float, __builtin_amdgcn_readlane(__builtin_bit_cast(int, s1), kk)), w, a1);
            a2 = fmaf(__builtin_bit_cast(float, __builtin_amdgcn_readlane(__builtin_bit_cast(int, s2), kk)), w, a2);
        }
    }
    const float b = C.a->in[I_ADAB][layer * 6144 + col];
    MOD[(size_t)(layer * 3 + 0) * 6144 + col] = a0 + b;
    MOD[(size_t)(layer * 3 + 1) * 6144 + col] = a1 + b;
    MOD[(size_t)(layer * 3 + 2) * 6144 + col] = a2 + b;
}
__device__ __forceinline__ void rope_tables(float* ROPE, int t) {
    if (t >= 8) return;
    const double invf[8] = {1.0, 0.31622776601683794, 0.1, 0.031622776601683794, 0.01, 0.0031622776601683794, 0.001, 0.00031622776601683794};
    double th = 1.0;
#pragma unroll
    for (int f = 0; f < 8; ++f) th = (t == f) ? invf[f] : th;
    double s = 0.0, c = 0.0, term = 1.0;
#pragma unroll
    for (int n = 0; n < 22; ++n) { if ((n & 1) == 0) c += ((n & 2) ? -term : term); else s += ((n & 2) ? -term : term); term = term * th / (double)(n + 1); }
    double cr = 1.0, sr = 0.0;
    for (int p = 0; p < 64; ++p) { ROPE[p * 8 + t] = (float)cr; ROPE[512 + p * 8 + t] = (float)sr; const double c2 = cr * c - sr * s, s2 = sr * c + cr * s; cr = c2; sr = s2; }
}

#define JOB(n, call) { const int _n = (n); if (r < _n) { call; continue; } r -= _n; }
__device__ __forceinline__ void phase0(const Ctx& C) {
    unsigned char* ws = C.a->ws; bf16_t* WB = (bf16_t*)(ws + WS_W);
    LAS float* scr = (LAS float*)(C.lds + C.wave * 16384);
    float* MOD = (float*)(ws + WS_MOD);
    if (C.gw == 0) rope_tables((float*)(ws + WS_ROPE), C.lane);
    const float* const* in = C.a->in;
    constexpr int T_GU = (1024 / 64) * (2816 / 32), T_D = (2816 / 64) * (1024 / 32);
    constexpr int T_QA = 16 * 12, T_KVA = 16 * 9, T_QB = 6 * 48, T_KVB = 4 * 64, T_SQ = 16 * 32, T_W1 = 16 * 2, T_G1 = 16 * 4, T_G2 = 2 * 32, T_PW = 4 * 8, T_W2 = 1 * 32;
    constexpr int N_ADA = 4 * 96;
    constexpr int TOTAL = N_ADA + 4 * (2 * T_GU + T_D) + 2 * (T_QA + T_KVA + T_QB + T_KVB + T_SQ) + 3 * T_SQ + 4 * T_W1 + T_G1 + T_G2 + T_SQ + 4 * T_PW + 4 * T_W2
                        + 2 * (96 * 1024 / 8 / 64) + 3 * (128 * 1024 / 8 / 64) + (1024 * 128 / 8 / 64);
    for (int it = C.gw; it < TOTAL; it += C.NGW) {
        int r = it;
        JOB(N_ADA, adaln_item(C, r, MOD));
        bool done = false;
#pragma unroll 1
        for (int L = 0; L < 4 && !done; ++L) {
            bf16_t* gu = (bf16_t*)((unsigned char*)WB + L * W_FFN_STRIDE + W_FFN_GU); bf16_t* wd = (bf16_t*)((unsigned char*)WB + L * W_FFN_STRIDE + W_FFN_D);
            if (r < T_GU) { conv_tile(in[I_WG] + (size_t)L * 1024 * 2816, 2816, 88, r, gu, 1024, 0, MAP_GU, 0, scr, C.lane); done = true; break; } r -= T_GU;
            if (r < T_GU) { conv_tile(in[I_WU] + (size_t)L * 1024 * 2816, 2816, 88, r, gu, 1024, 0, MAP_GU, 1, scr, C.lane); done = true; break; } r -= T_GU;
            if (r < T_D)  { conv_tile(in[I_WD] + (size_t)L * 2816 * 1024, 1024, 32, r, wd, 2816, 0, MAP_ID, 0, scr, C.lane); done = true; break; } r -= T_D;
        }
        if (done) continue;
#pragma unroll 1
        for (int j = 0; j < 2 && !done; ++j) {
            unsigned char* wm = (unsigned char*)WB + W_MLA + j * W_MLA_STRIDE;
            if (r < T_QA)  { conv_tile(in[I_WQA] + (size_t)j * 1024 * 384, 384, 12, r, (bf16_t*)(wm + W_MLA_1), 1024, 0, MAP_ID, 0, scr, C.lane); done = true; break; } r -= T_QA;
            if (r < T_KVA) { conv_tile(in[I_WKVA] + (size_t)j * 1024 * 288, 288, 9, r, (bf16_t*)(wm + W_MLA_1), 1024, 0, MAP_KVA, 0, scr, C.lane); done = true; break; } r -= T_KVA;
            if (r < T_QB)  { conv_tile(in[I_WQB] + (size_t)j * 384 * 1536, 1536, 48, r, (bf16_t*)(wm + W_MLA_QB), 384, 0, MAP_QB, 0, scr, C.lane); done = true; break; } r -= T_QB;
            if (r < T_KVB) { conv_tile(in[I_WKVB] + (size_t)j * 256 * 2048, 2048, 64, r, (bf16_t*)(wm + W_MLA_KVB), 256, 0, MAP_ID, 0, scr, C.lane); done = true; break; } r -= T_KVB;
            if (r < T_SQ)  { conv_tile(in[I_MWO] + (size_t)j * 1024 * 1024, 1024, 32, r, (bf16_t*)(wm + W_MLA_O), 1024, 0, MAP_ID, 0, scr, C.lane); done = true; break; } r -= T_SQ;
        }
        if (done) continue;
        unsigned char* wr = (unsigned char*)WB + W_RW;
        bf16_t* w1c = (bf16_t*)(wr + W_RW_1);
        JOB(T_SQ, conv_tile(in[I_WR], 1024, 32, r, w1c, 1024, 0, MAP_ID, 0, scr, C.lane));
        JOB(T_SQ, conv_tile(in[I_WK], 1024, 32, r, w1c, 1024, 0, MAP_ID, 1024, scr, C.lane));
        JOB(T_SQ, conv_tile(in[I_WV], 1024, 32, r, w1c, 1024, 0, MAP_ID, 2048, scr, C.lane));
        JOB(T_W1, conv_tile(in[I_W1], 64, 2, r, w1c, 1024, 0, MAP_ID, 3072, scr, C.lane));
        JOB(T_W1, conv_tile(in[I_W1] + 1024 * 64, 64, 2, r, w1c, 1024, 0, MAP_ID, 3072 + 64, scr, C.lane));
        JOB(T_W1, conv_tile(in[I_A1], 64, 2, r, w1c, 1024, 0, MAP_ID, 3328, scr, C.lane));
        JOB(T_W1, conv_tile(in[I_A1] + 1024 * 64, 64, 2, r, w1c, 1024, 0, MAP_ID, 3328 + 64, scr, C.lane));
        JOB(T_G1, conv_tile(in[I_G1], 128, 4, r, w1c, 1024, 0, MAP_ID, 3584, scr, C.lane));
        JOB(T_G2, conv_tile(in[I_G2], 1024, 32, r, (bf16_t*)(wr + W_RW_G2T), 256, 0, MAP_ID, 0, scr, C.lane));
        JOB(T_SQ, conv_tile(in[I_RWO], 1024, 32, r, (bf16_t*)(wr + W_RW_O), 1024, 0, MAP_ID, 0, scr, C.lane));
        JOB(T_PW, conv_tile(in[I_POOLW] + 0 * 65536, 256, 8, r, (bf16_t*)((unsigned char*)WB + W_POOL), 256, 0, MAP_ID, 0, scr, C.lane));
        JOB(T_PW, conv_tile(in[I_POOLW] + 1 * 65536, 256, 8, r, (bf16_t*)((unsigned char*)WB + W_POOL), 256, 0, MAP_ID, 256, scr, C.lane));
        JOB(T_PW, conv_tile(in[I_POOLW] + 2 * 65536, 256, 8, r, (bf16_t*)((unsigned char*)WB + W_POOL), 256, 0, MAP_ID, 512, scr, C.lane));
        JOB(T_PW, conv_tile(in[I_POOLW] + 3 * 65536, 256, 8, r, (bf16_t*)((unsigned char*)WB + W_POOL), 256, 0, MAP_ID, 768, scr, C.lane));
        JOB(T_W2, conv_tile(in[I_W2], 1024, 32, r, (bf16_t*)(wr + W_RW_W2T), 64, 0, MAP_ID, 0, scr, C.lane));
        JOB(T_W2, conv_tile(in[I_W2] + 64 * 1024, 1024, 32, r, (bf16_t*)(wr + W_RW_W2T), 64, 0, MAP_ID, 1024, scr, C.lane));
        JOB(T_W2, conv_tile(in[I_A2], 1024, 32, r, (bf16_t*)(wr + W_RW_A2T), 64, 0, MAP_ID, 0, scr, C.lane));
        JOB(T_W2, conv_tile(in[I_A2] + 64 * 1024, 1024, 32, r, (bf16_t*)(wr + W_RW_A2T), 64, 0, MAP_ID, 1024, scr, C.lane));
        JOB(96 * 1024 / 8 / 64, zero_rect_item((bf16_t*)((unsigned char*)WB + W_MLA + W_MLA_1), 1024, 672, 0, 1024, r, C.lane));
        JOB(96 * 1024 / 8 / 64, zero_rect_item((bf16_t*)((unsigned char*)WB + W_MLA + W_MLA_STRIDE + W_MLA_1), 1024, 672, 0, 1024, r, C.lane));
        JOB(128 * 1024 / 8 / 64, zero_rect_item(w1c, 1024, 3200, 0, 1024, r, C.lane));
        JOB(128 * 1024 / 8 / 64, zero_rect_item(w1c, 1024, 3456, 0, 1024, r, C.lane));
        JOB(128 * 1024 / 8 / 64, zero_rect_item(w1c, 1024, 3712, 0, 1024, r, C.lane));
        JOB(1024 * 128 / 8 / 64, zero_rect_item((bf16_t*)(wr + W_RW_G2T), 256, 0, 128, 128, r, C.lane));
    }
}

__device__ __forceinline__ void store_h_row(bf16_t* Hrow, const f32x4 (&x)[4], const float* sh, const float* sc, int lane) {
#pragma unroll
    for (int j = 0; j < 4; ++j) { const int c = 4 * lane + 256 * j; const f32x4 s = *(const f32x4*)(sc + c), t = *(const f32x4*)(sh + c);
        u32x2 o; o.x = pk2(x[j].x * (1.f + s.x) + t.x, x[j].y * (1.f + s.y) + t.y); o.y = pk2(x[j].z * (1.f + s.z) + t.z, x[j].w * (1.f + s.w) + t.w);
        *(u32x2*)(Hrow + c) = o; }
}
__device__ __forceinline__ void phase_init(const Ctx& C) {
    unsigned char* ws = C.a->ws; float* X = (float*)(ws + WS_X); bf16_t* H = (bf16_t*)(ws + WS_H); const float* MOD = (const float*)(ws + WS_MOD);
    for (int row = C.gw; row < MROWS; row += C.NGW) {
        const float* src = row < NPR ? C.a->in[I_XP] + (size_t)row * DM : C.a->in[I_XS] + (size_t)(row - NPR) * DM;
        f32x4 x[4];
#pragma unroll
        for (int j = 0; j < 4; ++j) { x[j] = *(const f32x4*)(src + 4 * C.lane + 256 * j); *(f32x4*)(X + (size_t)row * DM + 4 * C.lane + 256 * j) = x[j]; }
        const int cd = cond_of_row(row);
        store_h_row(H + (size_t)row * DM, x, modp(MOD, 0, cd, 0), modp(MOD, 0, cd, 1), C.lane);
    }
}
__device__ __forceinline__ void phase_ln(const Ctx& C, int layer, int which, int hl, int hs, bool to_out) {
    unsigned char* ws = C.a->ws; float* X = (float*)(ws + WS_X); bf16_t* H = (bf16_t*)(ws + WS_H); const float* MOD = (const float*)(ws + WS_MOD);
    const float* g = C.a->in[I_LNG] + (size_t)(layer * 2 + which) * DM; const float* b = C.a->in[I_LNB] + (size_t)(layer * 2 + which) * DM;
    for (int row = C.gw; row < MROWS; row += C.NGW) {
        float* xr = X + (size_t)row * DM; f32x4 x[4]; float s = 0.f;
#pragma unroll
        for (int j = 0; j < 4; ++j) { x[j] = *(const f32x4*)(xr + 4 * C.lane + 256 * j); s += (x[j].x + x[j].y) + (x[j].z + x[j].w); }
        const float mean = wave_sum(s) * (1.f / DM); float q = 0.f;
#pragma unroll
        for (int j = 0; j < 4; ++j) { x[j] = x[j] - mean; q += (x[j].x * x[j].x + x[j].y * x[j].y) + (x[j].z * x[j].z + x[j].w * x[j].w); }
        const float rstd = 1.0f / sqrtf(wave_sum(q) * (1.f / DM) + 1e-5f);
#pragma unroll
        for (int j = 0; j < 4; ++j) { const int c = 4 * C.lane + 256 * j; const f32x4 gg = *(const f32x4*)(g + c), bb = *(const f32x4*)(b + c);
            x[j] = x[j] * rstd * gg + bb; *(f32x4*)(xr + c) = x[j];
            if (to_out) *(f32x4*)(C.a->out + (size_t)row * DM + c) = x[j]; }
        if (hs >= 0) { const int cd = cond_of_row(row); store_h_row(H + (size_t)row * DM, x, modp(MOD, hl, cd, hs), modp(MOD, hl, cd, hs + 1), C.lane); }
    }
}

template <class ASel, class Epi>
__device__ __forceinline__ void gemm_simple(const Ctx& C, const ASel& asel, int lda, const bf16_t* Bt, int ldb, int Mr, int N, int K, const Epi& epi) {
    const int nTm = Mr >> 6, nTn = N >> 6, fr = C.lane & 15, fq = C.lane >> 4;
    for (int t = C.gw; t < nTm * nTn; t += C.NGW) {
        const int tm = t / nTn, tn = t - tm * nTn, m0 = tm * 64, n0 = tn * 64;
        const bf16_t* A = asel(n0);
        f32x4 acc[4][2][2];
#pragma unroll
        for (int mi = 0; mi < 4; ++mi)
#pragma unroll
            for (int g = 0; g < 2; ++g) { acc[mi][g][0] = (f32x4){0.f, 0.f, 0.f, 0.f}; acc[mi][g][1] = (f32x4){0.f, 0.f, 0.f, 0.f}; }
        const bf16_t* ap = A + (size_t)(m0 + fr) * lda + 8 * fq;
        const bf16_t* bp0 = Bt + (size_t)(n0 + perm32(fr)) * ldb + 8 * fq;
        const bf16_t* bp1 = Bt + (size_t)(n0 + perm32(16 + fr)) * ldb + 8 * fq;
        for (int k0 = 0; k0 < K; k0 += 32) {
            bf16x8 af[4], bf[2][2];
#pragma unroll
            for (int mi = 0; mi < 4; ++mi) af[mi] = *(const bf16x8*)(ap + (size_t)(16 * mi) * lda + k0);
#pragma unroll
            for (int g = 0; g < 2; ++g) { bf[g][0] = *(const bf16x8*)(bp0 + (size_t)(32 * g) * ldb + k0); bf[g][1] = *(const bf16x8*)(bp1 + (size_t)(32 * g) * ldb + k0); }
#pragma unroll
            for (int mi = 0; mi < 4; ++mi)
#pragma unroll
                for (int g = 0; g < 2; ++g) {
                    acc[mi][g][0] = __builtin_amdgcn_mfma_f32_16x16x32_bf16(bf[g][0], af[mi], acc[mi][g][0], 0, 0, 0);
                    acc[mi][g][1] = __builtin_amdgcn_mfma_f32_16x16x32_bf16(bf[g][1], af[mi], acc[mi][g][1], 0, 0, 0);
                }
        }
#pragma unroll
        for (int mi = 0; mi < 4; ++mi)
#pragma unroll
            for (int g = 0; g < 2; ++g) epi(m0 + 16 * mi + fr, n0 + 32 * g + 8 * fq, acc[mi][g][0], acc[mi][g][1]);
    }
}
struct ASelPlain { const bf16_t* A; __device__ __forceinline__ const bf16_t* operator()(int) const { return A; } };
struct ASelShift { const bf16_t* A; int shift; size_t stride; __device__ __forceinline__ const bf16_t* operator()(int n0) const { return A + (size_t)(n0 >> shift) * stride; } };

struct EpiF32 { float* out; int ldc;
    __device__ __forceinline__ void operator()(int row, int c0, f32x4 v0, f32x4 v1) const { float* o = out + (size_t)row * ldc + c0; *(f32x4*)o = v0; *(f32x4*)(o + 4) = v1; } };
struct EpiBf16 { bf16_t* out; int ldc;
    __device__ __forceinline__ void operator()(int row, int c0, f32x4 v0, f32x4 v1) const {
        u32x4 w; w.x = pk2(v0.x, v0.y); w.y = pk2(v0.z, v0.w); w.z = pk2(v1.x, v1.y); w.w = pk2(v1.z, v1.w); *(u32x4*)(out + (size_t)row * ldc + c0) = w; } };
struct EpiSwiglu { bf16_t* act;
    __device__ __forceinline__ void operator()(int row, int c0, f32x4 v0, f32x4 v1) const {
        u32x2 w; w.x = pk2(siluf_(v0.x) * v1.x, siluf_(v0.y) * v1.y); w.y = pk2(siluf_(v0.z) * v1.z, siluf_(v0.w) * v1.w);
        *(u32x2*)(act + (size_t)row * DFF + (c0 >> 1)) = w; } };
struct EpiResid { float* X; const float* MOD; int layer, gslot; const float* cscale;
    __device__ __forceinline__ void operator()(int row, int c0, f32x4 v0, f32x4 v1) const {
        const float* gt = modp(MOD, layer, cond_of_row(row), gslot) + c0; float* x = X + (size_t)row * DM + c0;
        f32x4 g0 = *(const f32x4*)gt, g1 = *(const f32x4*)(gt + 4);
        if (cscale) { g0 = g0 * *(const f32x4*)(cscale + c0); g1 = g1 * *(const f32x4*)(cscale + c0 + 4); }
        const f32x4 x0 = *(const f32x4*)x, x1 = *(const f32x4*)(x + 4);
        *(f32x4*)x = x0 * ALPHA + g0 * v0; *(f32x4*)(x + 4) = x1 * ALPHA + g1 * v1; } };
struct EpiRwA { bf16_t* R;
    __device__ __forceinline__ void operator()(int row, int c0, f32x4 v0, f32x4 v1) const {
        u32x4 w; w.x = pk2(v0.x, v0.y); w.y = pk2(v0.z, v0.w); w.z = pk2(v1.x, v1.y); w.w = pk2(v1.z, v1.w);
        *(u32x4*)(R + (size_t)(c0 >> 10) * ((size_t)MROWS * DM) + (size_t)row * DM + (c0 & 1023)) = w; } };
struct EpiRwB { bf16_t* T2; bf16_t* SG;
    __device__ __forceinline__ void operator()(int row, int c0, f32x4 v0, f32x4 v1) const {
        const int tile = c0 >> 8, cc = c0 & 255;
        if (tile == 0) { if (cc >= 128) return;
            u32x4 w; w.x = pk2(tanhf(v0.x), tanhf(v0.y)); w.y = pk2(tanhf(v0.z), tanhf(v0.w)); w.z = pk2(tanhf(v1.x), tanhf(v1.y)); w.w = pk2(tanhf(v1.z), tanhf(v1.w));
            *(u32x4*)(T2 + (size_t)row * 256 + cc) = w; }
        else if (tile == 1) { if (cc >= 128) return;
            u32x4 w; w.x = pk2(v0.x, v0.y); w.y = pk2(v0.z, v0.w); w.z = pk2(v1.x, v1.y); w.w = pk2(v1.z, v1.w);
            *(u32x4*)(T2 + (size_t)row * 256 + 128 + cc) = w; }
        else { u32x4 w; w.x = pk2(sigmoidf_(v0.x), sigmoidf_(v0.y)); w.y = pk2(sigmoidf_(v0.z), sigmoidf_(v0.w)); w.z = pk2(sigmoidf_(v1.x), sigmoidf_(v1.y)); w.w = pk2(sigmoidf_(v1.z), sigmoidf_(v1.w));
            *(u32x4*)(SG + (size_t)row * 256 + cc) = w; } } };
__device__ __forceinline__ int kv_row_of(int row) { return row < NPR ? row : NPR + ((row - NPR) >> 12) * 4608 + 512 + ((row - NPR) & 4095); }
__device__ __forceinline__ void phase_mla_norm(const Ctx& C, int j) {
    unsigned char* ws = C.a->ws; const float* R1 = (const float*)(ws + WS_SCR + S_R1);
    bf16_t* QA = (bf16_t*)(ws + WS_SCR + S_QA); bf16_t* CKV = (bf16_t*)(ws + WS_SCR + S_CKV); bf16_t* KPE = (bf16_t*)(ws + WS_SCR + S_KPE);
    const float* ROPE = (const float*)(ws + WS_ROPE);
    const float* qn = C.a->in[I_QNORM] + j * 384; const float* kvn = C.a->in[I_KVNORM] + j * 256; float* out = C.a->out;
    const int lane = C.lane;
    for (int row = C.gw; row < MROWS + 1024; row += C.NGW) {
        if (row < MROWS) {
            const float* r = R1 + (size_t)row * 768;
            f32x2 q[3]; float s = 0.f;
#pragma unroll
            for (int jj = 0; jj < 3; ++jj) { q[jj] = *(const f32x2*)(r + 2 * lane + 128 * jj); s += q[jj].x * q[jj].x + q[jj].y * q[jj].y; }
            const float rstd = 1.0f / sqrtf(wave_sum(s) * (1.f / 384.f) + 1e-6f);
#pragma unroll
            for (int jj = 0; jj < 3; ++jj) { const int c = 2 * lane + 128 * jj; const f32x2 g = *(const f32x2*)(qn + c);
                *(unsigned*)(QA + (size_t)row * 384 + c) = pk2(q[jj].x * rstd * g.x, q[jj].y * rstd * g.y); }
            const f32x4 kv = *(const f32x4*)(r + 384 + 4 * lane);
            const float rstd2 = 1.0f / sqrtf(wave_sum((kv.x * kv.x + kv.y * kv.y) + (kv.z * kv.z + kv.w * kv.w)) * (1.f / 256.f) + 1e-6f);
            const f32x4 o = kv * rstd2 * *(const f32x4*)(kvn + 4 * lane);
            const int kvrow = kv_row_of(row);
            u32x2 w; w.x = pk2(o.x, o.y); w.y = pk2(o.z, o.w);
            *(u32x2*)(CKV + (size_t)kvrow * 256 + 4 * lane) = w;
            const int b = row >> 8, t = row & 255;
            if (row < NPR) *(f32x4*)(out + OUT_CKV + ((size_t)(b * 2 + j) * 256 + t) * 256 + 4 * lane) = o;
            if (lane < 16) {
                const int p = lane, ax = p >> 3, f = p & 7;
                float x1 = r[640 + 2 * p], x2 = r[640 + 2 * p + 1];
                if (row < NPR) { float* ok = out + OUT_KPE + ((size_t)(b * 2 + j) * 256 + t) * 32 + ax * 16 + f; ok[0] = x1; ok[8] = x2; }
                else { const int tt = (row - NPR) & 4095; const int pos = ax == 0 ? (tt >> 6) : (tt & 63);
                    const float c = ROPE[pos * 8 + f], sn = ROPE[512 + pos * 8 + f]; const float o1 = x1 * c - x2 * sn, o2 = x1 * sn + x2 * c; x1 = o1; x2 = o2; }
                *(unsigned*)(KPE + (size_t)kvrow * 32 + 2 * p) = pk2(x1, x2);
            }
        } else {
            const int idx = row - MROWS, b = idx >> 9, i = idx & 511; const int kvrow = NPR + b * 4608 + i;
            const float* sc = C.a->in[I_CCKV] + ((size_t)(b * 2 + j) * 512 + i) * 256;
            const f32x4 v = *(const f32x4*)(sc + 4 * lane);
            u32x2 w; w.x = pk2(v.x, v.y); w.y = pk2(v.z, v.w);
            *(u32x2*)(CKV + (size_t)kvrow * 256 + 4 * lane) = w;
            if (lane < 16) { const int p = lane, ax = p >> 3, f = p & 7; const float* sk = C.a->in[I_CKPE] + ((size_t)(b * 2 + j) * 512 + i) * 32 + ax * 16 + f;
                *(unsigned*)(KPE + (size_t)kvrow * 32 + 2 * p) = pk2(sk[0], sk[8]); }
        }
    }
}

#define RDL(v, i) __builtin_bit_cast(float, __builtin_amdgcn_readlane(__builtin_bit_cast(int, (v)), (i)))
__device__ __forceinline__ void phase_attn_simple(const Ctx& C) {
    unsigned char* ws = C.a->ws; const bf16_t* Q = (const bf16_t*)(ws + WS_SCR + S_Q); const bf16_t* KV = (const bf16_t*)(ws + WS_SCR + S_KV);
    const bf16_t* KPE = (const bf16_t*)(ws + WS_SCR + S_KPE); bf16_t* O = (bf16_t*)(ws + WS_SCR + S_O); const float* ROPE = (const float*)(ws + WS_ROPE);
    const int lane = C.lane; const float scale = 0.10206207261596577f;
    for (int it = C.gw; it < MROWS * 16; it += C.NGW) {
        const int row = it >> 4, h = it & 15;
        int kbase, ntile;
        if (row < NPR) { kbase = row & ~255; ntile = 4; } else { kbase = NPR + ((row - NPR) >> 12) * 4608; ntile = 72; }
        const bf16_t* qrow = Q + (size_t)row * 1536 + h * 96;
        float qa = bf2f(qrow[lane]); float qb = bf2f(qrow[64 + (lane & 31)]);
        if (row >= NPR) { const int tt = (row - NPR) & 4095; const int p = (lane & 31) >> 1, ax = p >> 3, f = p & 7; const int pos = ax == 0 ? (tt >> 6) : (tt & 63);
            const float c = ROPE[pos * 8 + f], sn = ROPE[512 + pos * 8 + f]; const float other = __shfl_xor(qb, 1);
            qb = (lane & 1) ? (other * sn + qb * c) : (qb * c - other * sn); }
        qa *= scale; qb *= scale;
        float m = -1e30f, l = 0.f, acc = 0.f;
        for (int tile = 0; tile < ntile; ++tile) {
            const int key = kbase + tile * 64 + lane;
            const u32x4* kn = (const u32x4*)(KV + (size_t)key * 2048 + h * 128); const u32x4* kp = (const u32x4*)(KPE + (size_t)key * 32);
            float s = 0.f;
#pragma unroll
            for (int c8 = 0; c8 < 8; ++c8) { const u32x4 w = kn[c8];
                s = fmaf(RDL(qa, 8 * c8 + 0), bflo(w.x), s); s = fmaf(RDL(qa, 8 * c8 + 1), bfhi(w.x), s); s = fmaf(RDL(qa, 8 * c8 + 2), bflo(w.y), s); s = fmaf(RDL(qa, 8 * c8 + 3), bfhi(w.y), s);
                s = fmaf(RDL(qa, 8 * c8 + 4), bflo(w.z), s); s = fmaf(RDL(qa, 8 * c8 + 5), bfhi(w.z), s); s = fmaf(RDL(qa, 8 * c8 + 6), bflo(w.w), s); s = fmaf(RDL(qa, 8 * c8 + 7), bfhi(w.w), s); }
#pragma unroll
            for (int c8 = 0; c8 < 4; ++c8) { const u32x4 w = kp[c8];
                s = fmaf(RDL(qb, 8 * c8 + 0), bflo(w.x), s); s = fmaf(RDL(qb, 8 * c8 + 1), bfhi(w.x), s); s = fmaf(RDL(qb, 8 * c8 + 2), bflo(w.y), s); s = fmaf(RDL(qb, 8 * c8 + 3), bfhi(w.y), s);
                s = fmaf(RDL(qb, 8 * c8 + 4), bflo(w.z), s); s = fmaf(RDL(qb, 8 * c8 + 5), bfhi(w.z), s); s = fmaf(RDL(qb, 8 * c8 + 6), bflo(w.w), s); s = fmaf(RDL(qb, 8 * c8 + 7), bfhi(w.w), s); }
            const float mn = fmaxf(m, wave_max(s)); const float alpha = __expf(m - mn); const float p = __expf(s - mn);
            l = l * alpha + wave_sum(p); acc *= alpha; m = mn;
            const bf16_t* vb = KV + (size_t)(kbase + tile * 64) * 2048 + h * 128 + 64 + lane;
#pragma unroll 16
            for (int jj = 0; jj < 64; ++jj) acc = fmaf(RDL(p, jj), bf2f(vb[(size_t)jj * 2048]), acc);
        }
        O[(size_t)row * 1024 + h * 64 + lane] = (bf16_t)f2bf(acc / l);
    }
}

__device__ __forceinline__ void phase_rw_prep(const Ctx& C, int layer, int part) {
    unsigned char* ws = C.a->ws; const float* X = (const float*)(ws + WS_X); bf16_t* XA = (bf16_t*)(ws + WS_H + R_XA); const float* MOD = (const float*)(ws + WS_MOD);
    const float* mu = C.a->in[I_MU]; const int lane = C.lane;
    const int i0 = part == 0 ? 0 : 1, i1 = part == 0 ? 2 : 4, i2 = part == 0 ? 3 : 5;
    for (int row = C.gw; row < MROWS; row += C.NGW) {
        int t, T; if (row < NPR) { t = row & 255; T = 256; } else { t = (row - NPR) & 4095; T = 4096; }
        const int cd = cond_of_row(row); const float* sh = modp(MOD, layer, cd, 0); const float* sc = modp(MOD, layer, cd, 1);
        const float* xr = X + (size_t)row * DM;
#pragma unroll
        for (int j = 0; j < 4; ++j) { const int c = 4 * lane + 256 * j;
            const f32x4 s1 = *(const f32x4*)(sc + c) + 1.0f, s0 = *(const f32x4*)(sh + c);
            const f32x4 h = *(const f32x4*)(xr + c) * s1 + s0;
            f32x4 hp = (f32x4){0.f, 0.f, 0.f, 0.f}, hn = (f32x4){0.f, 0.f, 0.f, 0.f};
            if (t > 0) hp = *(const f32x4*)(xr - DM + c) * s1 + s0;
            if (t < T - 1) hn = *(const f32x4*)(xr + DM + c) * s1 + s0;
            const f32x4 xx = (hp + hn) * 0.5f - h;
            const f32x4 o0 = h + xx * *(const f32x4*)(mu + i0 * DM + c), o1 = h + xx * *(const f32x4*)(mu + i1 * DM + c), o2 = h + xx * *(const f32x4*)(mu + i2 * DM + c);
            u32x2 w; w.x = pk2(o0.x, o0.y); w.y = pk2(o0.z, o0.w); *(u32x2*)(XA + (size_t)row * DM + c) = w;
            w.x = pk2(o1.x, o1.y); w.y = pk2(o1.z, o1.w); *(u32x2*)(XA + (size_t)MROWS * DM + (size_t)row * DM + c) = w;
            w.x = pk2(o2.x, o2.y); w.y = pk2(o2.z, o2.w); *(u32x2*)(XA + (size_t)2 * MROWS * DM + (size_t)row * DM + c) = w; }
    }
}

__device__ __forceinline__ float dpp_x1(float v) { return __builtin_bit_cast(float, __builtin_amdgcn_mov_dpp(__builtin_bit_cast(int, v), 0xB1, 0xF, 0xF, true)); }
__device__ __forceinline__ float dpp_x2(float v) { return __builtin_bit_cast(float, __builtin_amdgcn_mov_dpp(__builtin_bit_cast(int, v), 0x4E, 0xF, 0xF, true)); }

constexpr int SCAN_BLK = 8;
__device__ __forceinline__ void scan_item(const Ctx& C, int row_first, int T, int h, int dir, int init, const float* initp, bool hasv, bf16_t* yout, float* endp, float* bon) {
    unsigned char* ws = C.a->ws; const float* const* in = C.a->in;
    const bf16_t* Rb = (const bf16_t*)(ws + WS_H + R_R); const bf16_t* Kb = (const bf16_t*)(ws + WS_H + R_K); const bf16_t* Vb = (const bf16_t*)(ws + WS_H + R_V);
    const bf16_t* T2 = (const bf16_t*)(ws + WS_H + R_T2);
    LAS float* opb = (LAS float*)(C.lds + C.wave * 16384);
    const int lane = C.lane, ks = lane & 3, vg = lane >> 2, ch = h * 64 + lane;
    const float w0c = in[I_W0][dir * DM + ch], a0c = in[I_A0][dir * DM + ch], kkc = in[I_KK][ch], kac = in[I_KA][ch], rkc = in[I_RK][ch];
    const float* w2p = in[I_W2] + (size_t)dir * 64 * DM + ch; const float* a2p = in[I_A2] + (size_t)dir * 64 * DM + ch;
    float S[4][16];
#pragma unroll
    for (int i = 0; i < 4; ++i)
#pragma unroll
        for (int j = 0; j < 16; ++j) S[i][j] = (init == 1) ? ((4 * vg + i == 16 * ks + j) ? 1.f : 0.f) : 0.f;
    if (init == 2) {
#pragma unroll
        for (int i = 0; i < 4; ++i)
#pragma unroll
            for (int q = 0; q < 4; ++q) { const f32x4 v = *(const f32x4*)(initp + (4 * vg + i) * 64 + 16 * ks + 4 * q); S[i][4 * q] = v.x; S[i][4 * q + 1] = v.y; S[i][4 * q + 2] = v.z; S[i][4 * q + 3] = v.w; }
    }
    for (int s0 = 0; s0 < T; s0 += SCAN_BLK) {
#pragma unroll 1
        for (int s = 0; s < SCAN_BLK; ++s) {
            const int row = dir == 0 ? row_first + s0 + s : row_first + T - 1 - (s0 + s);
            const float r = bf2f(Rb[(size_t)row * DM + ch]), k = bf2f(Kb[(size_t)row * DM + ch]), v = bf2f(Vb[(size_t)row * DM + ch]);
            const float tw = bf2f(T2[(size_t)row * 256 + dir * 64 + lane]), ta = bf2f(T2[(size_t)row * 256 + 128 + dir * 64 + lane]);
            float wpre = 0.f, apre = 0.f;
#pragma unroll 8
            for (int j = 0; j < 64; ++j) { wpre = fmaf(RDL(tw, j), w2p[(size_t)j * DM], wpre); apre = fmaf(RDL(ta, j), a2p[(size_t)j * DM], apre); }
            const float w = __expf(-0.6065306597126334f * sigmoidf_(w0c + wpre));
            const float a = sigmoidf_(a0c + apre);
            const float kkr = k * kkc; const float nrm = sqrtf(wave_sum(kkr * kkr)); const float kk = kkr / fmaxf(nrm, 1e-12f);
            const float kd = k * (1.0f + (a - 1.0f) * kac);
            const float bsum = wave_sum(r * kd * rkc);
            if (bon && lane == 0) bon[(size_t)row * 16 + h] = bsum;
            LAS float* o = opb + s * 384;
            o[lane] = -kk; o[64 + lane] = w; o[128 + lane] = kk * a; o[192 + lane] = kd; o[256 + lane] = r; o[320 + lane] = hasv ? v : 0.f;
        }
        asm volatile("s_waitcnt lgkmcnt(0)" ::: "memory");
#pragma unroll 1
        for (int s = 0; s < SCAN_BLK; ++s) {
            const int row = dir == 0 ? row_first + s0 + s : row_first + T - 1 - (s0 + s);
            const LAS float* o = opb + s * 384;
            float av[16], wv[16], bv[16], kv[16], rv[16];
#pragma unroll
            for (int q = 0; q < 4; ++q) {
                const f32x4 x0 = *(const LAS f32x4*)(o + 16 * ks + 4 * q), x1 = *(const LAS f32x4*)(o + 64 + 16 * ks + 4 * q), x2 = *(const LAS f32x4*)(o + 128 + 16 * ks + 4 * q),
                            x3 = *(const LAS f32x4*)(o + 192 + 16 * ks + 4 * q), x4 = *(const LAS f32x4*)(o + 256 + 16 * ks + 4 * q);
                av[4 * q] = x0.x; av[4 * q + 1] = x0.y; av[4 * q + 2] = x0.z; av[4 * q + 3] = x0.w;
                wv[4 * q] = x1.x; wv[4 * q + 1] = x1.y; wv[4 * q + 2] = x1.z; wv[4 * q + 3] = x1.w;
                bv[4 * q] = x2.x; bv[4 * q + 1] = x2.y; bv[4 * q + 2] = x2.z; bv[4 * q + 3] = x2.w;
                kv[4 * q] = x3.x; kv[4 * q + 1] = x3.y; kv[4 * q + 2] = x3.z; kv[4 * q + 3] = x3.w;
                rv[4 * q] = x4.x; rv[4 * q + 1] = x4.y; rv[4 * q + 2] = x4.z; rv[4 * q + 3] = x4.w;
            }
            const f32x4 vv4 = *(const LAS f32x4*)(o + 320 + 4 * vg); const float vv[4] = {vv4.x, vv4.y, vv4.z, vv4.w};
            float y[4];
#pragma unroll
            for (int i = 0; i < 4; ++i) {
                float sa = 0.f;
#pragma unroll
                for (int j = 0; j < 16; ++j) sa = fmaf(S[i][j], av[j], sa);
                sa += dpp_x1(sa); sa += dpp_x2(sa);
                float yy = 0.f;
#pragma unroll
                for (int j = 0; j < 16; ++j) { S[i][j] = fmaf(S[i][j], wv[j], fmaf(sa, bv[j], vv[i] * kv[j])); yy = fmaf(S[i][j], rv[j], yy); }
                yy += dpp_x1(yy); yy += dpp_x2(yy); y[i] = yy;
            }
            const float yo = ks == 0 ? y[0] : ks == 1 ? y[1] : ks == 2 ? y[2] : y[3];
            yout[(size_t)row * DM + h * 64 + lane] = (bf16_t)f2bf(yo);
        }
        asm volatile("s_waitcnt lgkmcnt(0)" ::: "memory");
    }
    if (endp) {
#pragma unroll
        for (int i = 0; i < 4; ++i)
#pragma unroll
            for (int q = 0; q < 4; ++q) *(f32x4*)(endp + (4 * vg + i) * 64 + 16 * ks + 4 * q) = (f32x4){S[i][4 * q], S[i][4 * q + 1], S[i][4 * q + 2], S[i][4 * q + 3]};
    }
}
__device__ __forceinline__ void phase_rw_scan_seq(const Ctx& C) {
    unsigned char* ws = C.a->ws; bf16_t* Y = (bf16_t*)(ws + WS_H + R_Y); float* BON = (float*)(ws + WS_H + R_BON);
    for (int it = C.gw; it < 1088; it += C.NGW) {
        if (it < 64) { const int b = it >> 5, h = (it >> 1) & 15, dir = it & 1;
            scan_item(C, NPR + b * 4096, 4096, h, dir, 2, C.a->in[I_SWKV] + ((size_t)(b * 2 + dir) * 16 + h) * 4096, true, Y + (size_t)dir * MROWS * DM, nullptr, BON + (size_t)dir * MROWS * 16);
        } else { const int q = it - 64, b = q >> 5, h = (q >> 1) & 15, dir = q & 1;
            scan_item(C, b * 256, 256, h, dir, 0, nullptr, true, Y + (size_t)dir * MROWS * DM, C.a->out + OUT_WKV + ((size_t)(b * 2 + dir) * 16 + h) * 4096, BON + (size_t)dir * MROWS * 16); }
    }
}
__device__ __forceinline__ void phase_rw_post(const Ctx& C) {
    unsigned char* ws = C.a->ws; bf16_t* Y0 = (bf16_t*)(ws + WS_H + R_Y); const bf16_t* Y1 = Y0 + (size_t)MROWS * DM; const float* BON = (const float*)(ws + WS_H + R_BON);
    const bf16_t* Vb = (const bf16_t*)(ws + WS_H + R_V); const bf16_t* G = (const bf16_t*)(ws + WS_H + R_G);
    const float* lg = C.a->in[I_LNXG]; const float* lb = C.a->in[I_LNXB]; const int lane = C.lane;
    for (int it = C.gw; it < MROWS * 16; it += C.NGW) {
        const int row = it >> 4, h = it & 15, c = h * 64 + lane; const size_t e = (size_t)row * DM + c;
        const float y = bf2f(Y0[e]) + bf2f(Y1[e]);
        const float mean = wave_sum(y) * (1.f / 64.f); const float d = y - mean; const float var = wave_sum(d * d) * (1.f / 64.f);
        const float yn = d * (1.0f / sqrtf(var + 64e-5f)) * lg[c] + lb[c];
        const float bonus = (BON[(size_t)row * 16 + h] + BON[(size_t)MROWS * 16 + (size_t)row * 16 + h]) * bf2f(Vb[e]);
        Y0[e] = (bf16_t)f2bf((yn + bonus) * bf2f(G[e]));
    }
}

__device__ __forceinline__ void phase_pool_prep(const Ctx& C, int layer) {
    unsigned char* ws = C.a->ws; const float* X = (const float*)(ws + WS_X); bf16_t* P = (bf16_t*)(ws + WS_SCR + S_POOL); const float* MOD = (const float*)(ws + WS_MOD);
    const int lane = C.lane;
    for (int row = C.gw; row < MROWS; row += C.NGW) {
        int t, T; if (row < NPR) { t = row & 255; T = 256; } else { t = (row - NPR) & 4095; T = 4096; }
        const float* sc = modp(MOD, layer, cond_of_row(row), 1); const float* xr = X + (size_t)row * DM;
#pragma unroll
        for (int j = 0; j < 4; ++j) { const int c = 4 * lane + 256 * j; const int win = 2 << j;
            int lo = t - win / 2, hi = t - win / 2 + win; lo = lo < 0 ? 0 : lo; hi = hi > T ? T : hi;
            f32x4 s = (f32x4){0.f, 0.f, 0.f, 0.f};
            for (int u = lo; u < hi; ++u) s = s + *(const f32x4*)(xr + (ptrdiff_t)(u - t) * DM + c);
            const f32x4 o = (*(const f32x4*)(sc + c) + 1.0f) * (s * (1.0f / (float)(hi - lo)) - *(const f32x4*)(xr + c));
            u32x2 w; w.x = pk2(o.x, o.y); w.y = pk2(o.z, o.w); *(u32x2*)(P + (size_t)row * DM + c) = w; }
    }
}
namespace pg8 {
#define PG8_LAS __attribute__((address_space(3)))
constexpr int BM = 256, BK = 64, HALF = 128, HTB = HALF * BK * 2, STAGE_BYTES = 8 * HTB, NXCD = 8, WGM = 8;
__host__ __device__ __forceinline__ int lds_byte(int r, int c) { const int st = (r >> 4) * 2 + (c >> 5), rr = r & 15, cc = c & 31, ob = rr * 64 + cc * 2; return st * 1024 + (ob ^ (((ob >> 9) & 1) << 5)); }
__host__ __device__ __forceinline__ void stage_rc(int b, int& R, int& C) { const int st = b / 1024, sb = b % 1024, swz = sb ^ (((sb >> 9) & 1) << 5); R = (st >> 1) * 16 + swz / 64; C = (st & 1) * 32 + (swz % 64) / 2; }
struct Unit { int pm, pn; };
struct Gemm { const bf16_t* Bt; int lda, ldb, K; };
struct StaticOrder {
    int nM, nN, nwg, G, c;
    __host__ __device__ void init(int M, int N, int G_, int c_) { nM = M / BM; nN = N / BM; nwg = nM * nN; G = G_; c = c_; }
    __host__ __device__ bool next(int i, Unit& u) const {
        const long L = (long)i * G + c; if (L >= nwg) return false;
        int wgid = (int)L; { const int q = nwg / NXCD, r = nwg % NXCD, xcd = wgid % NXCD, off = wgid / NXCD; wgid = (xcd < r ? xcd * (q + 1) : r * (q + 1) + (xcd - r) * q) + off; }
        const int nig = WGM * nN, gid = wgid / nig, fm = gid * WGM, gsz = (nM - fm) < WGM ? (nM - fm) : WGM;
        u.pm = fm + ((wgid % nig) % gsz); u.pn = (wgid % nig) / gsz; return true;
    }
    __device__ __forceinline__ void a_ready(const Unit&) const {}
    __device__ __forceinline__ void done(const Unit&) const {}
};
template <class E8> struct EpiWrap {
    static constexpr bool PERM = true, AFTER_DRAIN = false; E8 e;
    __device__ __forceinline__ void operator()(const f32x4 (&acc)[2][2][4][2], const Unit& u, int wr, int wc, int fr, int fq) const {
#pragma unroll
        for (int ai = 0; ai < 2; ++ai)
#pragma unroll
            for (int m = 0; m < 4; ++m) { const int row = u.pm * BM + ai * HALF + wr * 64 + m * 16 + fr;
#pragma unroll
                for (int bj = 0; bj < 2; ++bj) e(row, u.pn * BM + bj * HALF + wc * 32 + 8 * fq, acc[ai][bj][m][0], acc[ai][bj][m][1]); }
    }
};
template <class Epi, class ASel, class Sched, bool ALIGN_EPI = false, bool SP2 = false>
__device__ __forceinline__ void gemm_phase(PG8_LAS unsigned char* lds, const Gemm g, const ASel& asel, const Sched& S, const Epi& E) {
    const int tid = threadIdx.x, wid = __builtin_amdgcn_readfirstlane(tid >> 6), lane = tid & 63, wr = wid >> 2, wc = wid & 3, fr = lane & 15, fq = lane >> 4;
    const int K = g.K, nt = K / BK;
    unsigned voffA[2], voffB[2];
#pragma unroll
    for (int i = 0; i < 2; ++i) { int R, C; stage_rc(tid * 16 + i * 8192, R, C); const int Rb = Epi::PERM ? ((R & ~31) + perm32(R & 31)) : R;
        voffA[i] = (unsigned)(R * g.lda + C) * 2u; voffB[i] = (unsigned)(Rb * g.ldb + C) * 2u; }
    const size_t kstep = (size_t)(BK * 2);
    const size_t hstepA = (size_t)HALF * g.lda * 2, hstepB = (size_t)HALF * g.ldb * 2;
    const size_t tstepA = 2 * hstepA, tstepB = 2 * hstepB;
    const unsigned ldsw = (unsigned)wid * 1024u;
    const int aoff = lds_byte(wr * 64 + fr, fq * 8), boff = lds_byte(wc * 32 + fr, fq * 8);
#define PG8_SA(b, h) (((b) * 2 + (h)) * HTB)
#define PG8_SB(b, h) ((4 + (b) * 2 + (h)) * HTB)
#define PG8_STAGE(bufoff, gbase, voff) do { _Pragma("unroll") for (int _i = 0; _i < 2; ++_i) \
        __builtin_amdgcn_global_load_lds((const unsigned*)((const char*)(gbase) + (voff)[_i]), (PG8_LAS unsigned*)(lds + (bufoff) + ldsw + _i * 8192), 16, 0, 0); } while (0)
#define PG8_LDA(dst, b, h) do { _Pragma("unroll") for (int m = 0; m < 4; ++m) _Pragma("unroll") for (int k = 0; k < 2; ++k) dst[m][k] = *(const PG8_LAS bf16x8*)(lds + PG8_SA(b, h) + aoff + m * 2048 + k * 1024); } while (0)
#define PG8_LDB(dst, b, h) do { _Pragma("unroll") for (int n = 0; n < 2; ++n) _Pragma("unroll") for (int k = 0; k < 2; ++k) dst[n][k] = *(const PG8_LAS bf16x8*)(lds + PG8_SB(b, h) + boff + n * 2048 + k * 1024); } while (0)
#define PG8_MMA(ai, bj, At, Bt) do { __builtin_amdgcn_s_setprio(1); _Pragma("unroll") for (int m = 0; m < 4; ++m) _Pragma("unroll") for (int n = 0; n < 2; ++n) _Pragma("unroll") for (int k = 0; k < 2; ++k) \
        acc[ai][bj][m][n] = __builtin_amdgcn_mfma_f32_16x16x32_bf16(Bt[n][k], At[m][k], acc[ai][bj][m][n], 0, 0, 0); __builtin_amdgcn_s_setprio(0); } while (0)
#define PG8_WAIT_V(n) asm volatile("s_waitcnt vmcnt(" #n ")" ::: "memory")
#define PG8_WAIT_L(n) asm volatile("s_waitcnt lgkmcnt(" #n ")" ::: "memory")
#define PG8_BAR __builtin_amdgcn_s_barrier()
#define PG8_SCHED __builtin_amdgcn_sched_barrier(0)
    Unit cur, nxt; int ui = 0;
    if (!S.next(0, cur)) return;
    f32x4 acc[2][2][4][2];
#pragma unroll
    for (int a = 0; a < 2; ++a)
#pragma unroll
        for (int b = 0; b < 2; ++b)
#pragma unroll
            for (int m = 0; m < 4; ++m)
#pragma unroll
                for (int n = 0; n < 2; ++n) acc[a][b][m][n] = (f32x4){0.f, 0.f, 0.f, 0.f};
    bf16x8 At[4][2], B0[2][2], B1[2][2];
    const char* cA = (const char*)asel(cur.pn * BM) + (size_t)cur.pm * tstepA; const char* cB = (const char*)g.Bt + (size_t)cur.pn * tstepB;
    S.a_ready(cur);
    if constexpr (SP2) {
        PG8_STAGE(PG8_SB(0, 0), cB, voffB); PG8_STAGE(PG8_SB(0, 1), cB + hstepB, voffB); PG8_STAGE(PG8_SA(0, 0), cA, voffA); PG8_STAGE(PG8_SA(0, 1), cA + hstepA, voffA);
        if (wr == 1) PG8_BAR;
        PG8_WAIT_V(2); PG8_BAR;
        PG8_STAGE(PG8_SB(1, 0), cB + kstep, voffB); PG8_STAGE(PG8_SA(1, 0), cA + kstep, voffA); PG8_STAGE(PG8_SB(1, 1), cB + hstepB + kstep, voffB);
        PG8_WAIT_V(6); PG8_BAR;
    } else {
        PG8_STAGE(PG8_SB(0, 0), cB, voffB); PG8_STAGE(PG8_SA(0, 0), cA, voffA); PG8_STAGE(PG8_SB(0, 1), cB + hstepB, voffB); PG8_STAGE(PG8_SA(0, 1), cA + hstepA, voffA);
        if (wr == 1) PG8_BAR;
        PG8_WAIT_V(4); PG8_BAR;
        PG8_STAGE(PG8_SB(1, 0), cB + kstep, voffB); PG8_STAGE(PG8_SA(1, 0), cA + kstep, voffA); PG8_STAGE(PG8_SB(1, 1), cB + hstepB + kstep, voffB);
        PG8_WAIT_V(6); PG8_BAR;
    }
    for (;;) {
        const bool has_next = S.next(ui + 1, nxt);
        const char* nA = has_next ? (const char*)asel(nxt.pn * BM) + (size_t)nxt.pm * tstepA : cA; const char* nB = has_next ? (const char*)g.Bt + (size_t)nxt.pn * tstepB : cB;
        for (int t = 0; t < nt; t += 2) {
            const bool last = (t == nt - 2);
            const char* a1 = cA + (size_t)(t + 1) * kstep;
            const char* a2 = last ? nA : cA + (size_t)(t + 2) * kstep; const char* b2 = last ? nB : cB + (size_t)(t + 2) * kstep;
            const char* a3 = a2 + kstep; const char* b3 = b2 + kstep;
            if (last && has_next) S.a_ready(nxt);
            if constexpr (SP2) {
            PG8_LDB(B0, 0, 0); PG8_LDB(B1, 0, 1); PG8_SCHED; PG8_LDA(At, 0, 0); PG8_STAGE(PG8_SA(1, 1), a1 + hstepA, voffA);
            PG8_WAIT_V(8); PG8_WAIT_L(0); PG8_BAR; PG8_MMA(0, 0, At, B0); PG8_MMA(0, 1, At, B1); PG8_BAR; PG8_SCHED;
            PG8_LDA(At, 0, 1); PG8_STAGE(PG8_SB(0, 0), b2, voffB); PG8_STAGE(PG8_SB(0, 1), b2 + hstepB, voffB); PG8_STAGE(PG8_SA(0, 0), a2, voffA);
            PG8_WAIT_V(8); PG8_WAIT_L(0); PG8_BAR; PG8_MMA(1, 0, At, B0); PG8_MMA(1, 1, At, B1); PG8_BAR; PG8_SCHED;
            PG8_LDB(B0, 1, 0); PG8_LDB(B1, 1, 1); PG8_SCHED; PG8_LDA(At, 1, 0); PG8_STAGE(PG8_SA(0, 1), a2 + hstepA, voffA);
            PG8_WAIT_V(8); PG8_WAIT_L(0); PG8_BAR; PG8_MMA(0, 0, At, B0); PG8_MMA(0, 1, At, B1); PG8_BAR; PG8_SCHED;
            PG8_LDA(At, 1, 1); PG8_STAGE(PG8_SB(1, 0), b3, voffB); PG8_STAGE(PG8_SB(1, 1), b3 + hstepB, voffB); PG8_STAGE(PG8_SA(1, 0), a3, voffA);
            PG8_WAIT_V(8); PG8_WAIT_L(0); PG8_BAR; PG8_MMA(1, 0, At, B0); PG8_MMA(1, 1, At, B1); PG8_BAR; PG8_SCHED;
            } else {
            PG8_LDB(B0, 0, 0); PG8_SCHED; PG8_LDA(At, 0, 0); PG8_STAGE(PG8_SA(1, 1), a1 + hstepA, voffA);
            PG8_WAIT_L(8); PG8_BAR; PG8_WAIT_L(0); PG8_MMA(0, 0, At, B0); PG8_BAR; PG8_SCHED;
            PG8_LDB(B1, 0, 1); PG8_STAGE(PG8_SB(0, 0), b2, voffB);
            PG8_BAR; PG8_WAIT_L(0); PG8_MMA(0, 1, At, B1); PG8_BAR;
            PG8_LDA(At, 0, 1); PG8_STAGE(PG8_SA(0, 0), a2, voffA);
            PG8_BAR; PG8_WAIT_L(0); PG8_MMA(1, 0, At, B0); PG8_BAR; PG8_SCHED;
            PG8_STAGE(PG8_SB(0, 1), b2 + hstepB, voffB);
            PG8_WAIT_V(6); PG8_BAR; PG8_MMA(1, 1, At, B1); PG8_BAR;
            PG8_LDB(B0, 1, 0); PG8_SCHED; PG8_LDA(At, 1, 0); PG8_STAGE(PG8_SA(0, 1), a2 + hstepA, voffA);
            PG8_WAIT_L(8); PG8_BAR; PG8_WAIT_L(0); PG8_MMA(0, 0, At, B0); PG8_BAR; PG8_SCHED;
            PG8_LDB(B1, 1, 1); PG8_STAGE(PG8_SB(1, 0), b3, voffB);
            PG8_BAR; PG8_WAIT_L(0); PG8_MMA(0, 1, At, B1); PG8_BAR;
            PG8_LDA(At, 1, 1); PG8_STAGE(PG8_SA(1, 0), a3, voffA);
            PG8_BAR; PG8_WAIT_L(0); PG8_MMA(1, 0, At, B0); PG8_BAR; PG8_SCHED;
            PG8_STAGE(PG8_SB(1, 1), b3 + hstepB, voffB);
            PG8_WAIT_V(6); PG8_BAR; PG8_MMA(1, 1, At, B1); PG8_BAR;
            }
        }
        if constexpr (ALIGN_EPI) { if (wr == 0) PG8_BAR; }
        if constexpr (!Epi::AFTER_DRAIN) { E(acc, cur, wr, wc, fr, fq); S.done(cur); }
        if (!has_next) break;
#pragma unroll
        for (int a = 0; a < 2; ++a)
#pragma unroll
            for (int b = 0; b < 2; ++b)
#pragma unroll
                for (int m = 0; m < 4; ++m)
#pragma unroll
                    for (int n = 0; n < 2; ++n) acc[a][b][m][n] = (f32x4){0.f, 0.f, 0.f, 0.f};
        cur = nxt; cA = nA; cB = nB; ++ui;
        if constexpr (ALIGN_EPI) { if (wr == 1) PG8_BAR; }
    }
    PG8_WAIT_V(0);
    if constexpr (!ALIGN_EPI) { if (wr == 0) PG8_BAR; }
    PG8_BAR;
    if constexpr (Epi::AFTER_DRAIN) { E.fused(acc, cur, wr, wc, fr, fq, lds, wid, lane); S.done(cur); }
#undef PG8_SA
#undef PG8_SB
#undef PG8_STAGE
#undef PG8_LDA
#undef PG8_LDB
#undef PG8_MMA
#undef PG8_WAIT_V
#undef PG8_WAIT_L
#undef PG8_BAR
#undef PG8_SCHED
}
}
template <class ASel, class Epi>
__device__ __forceinline__ void gemm_fast(const Ctx& C, const ASel& asel, int lda, const bf16_t* Bt, int ldb, int Mr, int N, int K, const Epi& epi) {
    pg8::Gemm g{Bt, lda, ldb, K}; pg8::StaticOrder S; S.init(Mr, N, (int)gridDim.x, (int)blockIdx.x);
    pg8::EpiWrap<Epi> E{epi};
    pg8::gemm_phase<pg8::EpiWrap<Epi>, ASel, pg8::StaticOrder, true, true>(C.lds, g, asel, S, E);
}
namespace att {
using s16x4  = __attribute__((ext_vector_type(4))) short;
using f32x16 = __attribute__((ext_vector_type(16))) float;
constexpr int NW = 8, QBLK = 32, KVBLK = 64;
constexpr float SCALE = 0.10206207261596577f;
constexpr float THR = 8.f;
constexpr size_t SHM_V = KVBLK * 128 * 2, SHM_K = KVBLK * 128 * 2, SHM_ATTN = 2 * SHM_V + 2 * SHM_K + NW * 64 * 4;
#define KSWZ(row, colB) ((row) * 256 + ((colB) ^ (((row) & 7) << 4)))
#define SBAR() __builtin_amdgcn_sched_barrier(0)
__device__ __forceinline__ int crow(int r, int hi) { return (r & 3) + 8 * (r >> 2) + 4 * hi; }
__device__ __forceinline__ unsigned cvtpk(float lo, float hi) { unsigned r; asm volatile("v_cvt_pk_bf16_f32 %0, %1, %2" : "=v"(r) : "v"(lo), "v"(hi)); return r; }

__device__ __forceinline__ void partialSM(f32x16& p0, f32x16& p1, float& m_reg, float& mn, float& alpha) {
  constexpr float C = SCALE * 1.4426950408889634f;
  float pmax = p0[0];
#pragma unroll
  for (int r = 1; r < 16; ++r) pmax = fmaxf(pmax, p0[r]);
#pragma unroll
  for (int r = 0; r < 16; ++r) pmax = fmaxf(pmax, p1[r]);
  { auto rr = __builtin_amdgcn_permlane32_swap(__float_as_uint(pmax), __float_as_uint(pmax), false, false);
    pmax = fmaxf(__uint_as_float(rr[0]), __uint_as_float(rr[1])); }
  if (__builtin_expect(__all(pmax - m_reg <= THR / SCALE), 1)) { mn = m_reg; alpha = 1.f; }
  else { mn = fmaxf(m_reg, pmax); alpha = __builtin_amdgcn_exp2f((m_reg - mn) * C); m_reg = mn; }
  float mnC = -mn * C;
#pragma unroll
  for (int r = 0; r < 16; ++r) p0[r] = fmaf(p0[r], C, mnC);
#pragma unroll
  for (int r = 0; r < 16; ++r) p1[r] = fmaf(p1[r], C, mnC);
#pragma unroll
  for (int r = 0; r < 16; ++r) p0[r] = __builtin_amdgcn_exp2f(p0[r]);
}
__device__ __forceinline__ void finishSM(f32x16& p0, f32x16& p1, float alpha, float& l_reg, bf16x8& pa0, bf16x8& pa1, bf16x8& pa2, bf16x8& pa3) {
#pragma unroll
  for (int r = 0; r < 16; ++r) p1[r] = __builtin_amdgcn_exp2f(p1[r]);
  float ps = 0;
#pragma unroll
  for (int r = 0; r < 16; ++r) ps += p0[r];
#pragma unroll
  for (int r = 0; r < 16; ++r) ps += p1[r];
  { auto rr = __builtin_amdgcn_permlane32_swap(__float_as_uint(ps), __float_as_uint(ps), false, false);
    ps = __uint_as_float(rr[0]) + __uint_as_float(rr[1]); }
  l_reg = l_reg * alpha + ps;
#define PK4(P, BASE, OUT) do { unsigned a0 = cvtpk(P[BASE + 0], P[BASE + 1]), a1 = cvtpk(P[BASE + 2], P[BASE + 3]);   \
    unsigned b0 = cvtpk(P[BASE + 4], P[BASE + 5]), b1 = cvtpk(P[BASE + 6], P[BASE + 7]);                              \
    auto r0 = __builtin_amdgcn_permlane32_swap(a0, b0, false, false); auto r1 = __builtin_amdgcn_permlane32_swap(a1, b1, false, false); \
    u32x4 w = {r0[0], r1[0], r0[1], r1[1]}; OUT = *reinterpret_cast<bf16x8*>(&w); } while (0)
  PK4(p0, 0, pa0); PK4(p0, 8, pa1); PK4(p1, 0, pa2); PK4(p1, 8, pa3);
#undef PK4
}
__device__ __forceinline__ void qkt(f32x16& p0, f32x16& p1, const char* Ks, const bf16x8* qr, int r32, int hi) {
  p0 = f32x16{}; p1 = f32x16{};
#pragma unroll
  for (int d0 = 0; d0 < 6; ++d0) { int cb = (d0 * 16 + hi * 8) * 2;
    bf16x8 b0 = *reinterpret_cast<const bf16x8*>(Ks + KSWZ(r32, cb));
    bf16x8 b1 = *reinterpret_cast<const bf16x8*>(Ks + KSWZ(32 + r32, cb));
    p0 = __builtin_amdgcn_mfma_f32_32x32x16_bf16(b0, qr[d0], p0, 0, 0, 0);
    p1 = __builtin_amdgcn_mfma_f32_32x32x16_bf16(b1, qr[d0], p1, 0, 0, 0); }
}
__device__ __forceinline__ int v_st(int k, int c) { const int kk = (k & ~0xC) | ((k & 4) << 1) | ((k & 8) >> 1); return ((kk >> 3) * 4 + (c >> 5)) * 512 + ((kk & 7) * 32 + (c & 31)) * 2; }
__device__ __forceinline__ int v_rd_base(int lane) { return ((lane & 3) << 3) | (((lane >> 2) & 3) << 6) | (((lane >> 4) & 1) << 5) | (((lane >> 5) & 1) << 8); }
constexpr int v_rd_off(int d0, int ks, int half) { return d0 * 512 + ks * 4096 + half * 2048; }
template <int OFF> __device__ __forceinline__ s16x4 tr_read(int vb) {
  s16x4 r; asm volatile("ds_read_b64_tr_b16 %0, %1 offset:%2" : "=&v"(r) : "v"(vb), "i"(OFF) : "memory"); return r;
}
template <int D0> __device__ __forceinline__ void pv_one(f32x16& od, int vb, bf16x8 pa0, bf16x8 pa1, bf16x8 pa2, bf16x8 pa3) {
  const s16x4 l0 = tr_read<v_rd_off(D0, 0, 0)>(vb), h0 = tr_read<v_rd_off(D0, 0, 1)>(vb), l1 = tr_read<v_rd_off(D0, 1, 0)>(vb), h1 = tr_read<v_rd_off(D0, 1, 1)>(vb);
  const s16x4 l2 = tr_read<v_rd_off(D0, 2, 0)>(vb), h2 = tr_read<v_rd_off(D0, 2, 1)>(vb), l3 = tr_read<v_rd_off(D0, 3, 0)>(vb), h3 = tr_read<v_rd_off(D0, 3, 1)>(vb);
  asm volatile("s_waitcnt lgkmcnt(0)" ::: "memory"); SBAR();
#define PK(L, H) (bf16x8){L[0], L[1], L[2], L[3], H[0], H[1], H[2], H[3]}
  od = __builtin_amdgcn_mfma_f32_32x32x16_bf16(pa0, PK(l0, h0), od, 0, 0, 0);
  od = __builtin_amdgcn_mfma_f32_32x32x16_bf16(pa1, PK(l1, h1), od, 0, 0, 0);
  od = __builtin_amdgcn_mfma_f32_32x32x16_bf16(pa2, PK(l2, h2), od, 0, 0, 0);
  od = __builtin_amdgcn_mfma_f32_32x32x16_bf16(pa3, PK(l3, h3), od, 0, 0, 0);
#undef PK
}
__device__ __forceinline__ void pv_d0(f32x16* o, int vb, bf16x8 pa0, bf16x8 pa1, bf16x8 pa2, bf16x8 pa3) {
  pv_one<0>(o[0], vb, pa0, pa1, pa2, pa3); pv_one<1>(o[1], vb, pa0, pa1, pa2, pa3);
}

__device__ __forceinline__ void attn_unit(const bf16_t* __restrict__ Q, const bf16_t* __restrict__ KVm, const bf16_t* __restrict__ KPEm, bf16_t* __restrict__ O, const float* __restrict__ ROPE,
                                          int q0row, int k0row, int seq, int h, int rope_t0, char* lds) {
  const int tid = threadIdx.x, wid = tid >> 6, lane = tid & 63, r32 = lane & 31, hi = lane >> 5;
  char* V_lds = lds; char* K_lds = lds + 2 * SHM_V;
  float* ws = (float*)(lds + 2 * SHM_V + 2 * SHM_K) + wid * 64; float* li_l = ws; float* al_l = ws + 32;
  float m_reg = -1e30f, l_reg = 0; f32x16 o[2] = {}; bf16x8 qr[6];
  { const bf16_t* Qw = Q + (size_t)(q0row + wid * QBLK + r32) * 1536 + h * 96 + hi * 8;
#pragma unroll
    for (int d0 = 0; d0 < 6; ++d0) qr[d0] = *reinterpret_cast<const bf16x8*>(Qw + d0 * 16);
    if (rope_t0 >= 0) { const int t = rope_t0 + wid * QBLK + r32;
#pragma unroll
      for (int ax = 0; ax < 2; ++ax) { const int pos = ax == 0 ? (t >> 6) : (t & 63); u32x4 w = *reinterpret_cast<u32x4*>(&qr[4 + ax]); unsigned wv[4] = {w.x, w.y, w.z, w.w};
#pragma unroll
        for (int j = 0; j < 4; ++j) { const int f = 4 * hi + j; const float c = ROPE[pos * 8 + f], sn = ROPE[512 + pos * 8 + f]; const float x1 = bflo(wv[j]), x2 = bfhi(wv[j]);
          wv[j] = pk2(x1 * c - x2 * sn, x1 * sn + x2 * c); }
        w = (u32x4){wv[0], wv[1], wv[2], wv[3]}; qr[4 + ax] = *reinterpret_cast<bf16x8*>(&w); } } }
  const int sr = tid >> 4, sc = (tid & 15) * 8, vst0 = v_st(sr, sc), vst1 = v_st(32 + sr, sc);
  const int vb0 = (int)(uintptr_t)V_lds + v_rd_base(lane);
  const bf16_t* kp0; size_t kstride;
  if (sc < 64) { kp0 = KVm + (size_t)k0row * 2048 + h * 128 + sc; kstride = 2048; } else { kp0 = KPEm + (size_t)k0row * 32 + ((sc - 64) & 31); kstride = 32; }
  const bf16_t* vp0 = KVm + (size_t)k0row * 2048 + h * 128 + 64 + (sc & 63);
  struct { bf16x8 vs0, vs1, ks0, ks1; } sr_[2];
#define SLOAD(i, k0) do { sr_[i].vs0 = *(const bf16x8*)(vp0 + (size_t)((k0) + sr) * 2048); sr_[i].vs1 = *(const bf16x8*)(vp0 + (size_t)((k0) + 32 + sr) * 2048); \
    sr_[i].ks0 = *(const bf16x8*)(kp0 + (size_t)((k0) + sr) * kstride); sr_[i].ks1 = *(const bf16x8*)(kp0 + (size_t)((k0) + 32 + sr) * kstride); } while (0)
#define SWRITE(b, i) do { *(bf16x8*)(V_lds + (b) * SHM_V + vst0) = sr_[i].vs0; *(bf16x8*)(V_lds + (b) * SHM_V + vst1) = sr_[i].vs1; int kc = sc * 2; \
    *(bf16x8*)(K_lds + (b) * SHM_K + KSWZ(sr, kc)) = sr_[i].ks0; *(bf16x8*)(K_lds + (b) * SHM_K + KSWZ(32 + sr, kc)) = sr_[i].ks1; } while (0)
#define SWAIT() asm volatile("s_waitcnt vmcnt(4)" ::: "memory")
#define RESC(a) do { if (__any((a) < 1.f)) { if (hi == 0) al_l[r32] = (a); asm volatile("s_waitcnt lgkmcnt(0)" ::: "memory"); \
    _Pragma("unroll") for (int d = 0; d < 2; ++d) _Pragma("unroll") for (int r = 0; r < 16; ++r) o[d][r] *= al_l[crow(r, hi)]; } } while (0)
  f32x16 pA0, pA1, pB0, pB1; float mnA, mnB, alA, alB; bf16x8 pa0, pa1, pa2, pa3; const int NT = seq / KVBLK;
  constexpr int SE = 0, SO = 1;
  SLOAD(SE, 0); asm volatile("s_waitcnt vmcnt(0)" ::: "memory"); SWRITE(0, SE); __syncthreads();
  qkt(pA0, pA1, K_lds, qr, r32, hi); partialSM(pA0, pA1, m_reg, mnA, alA);
  SLOAD(SO, KVBLK); if (2 < NT) SLOAD(SE, 2 * KVBLK);
  SWAIT(); SWRITE(1, SO); __syncthreads();
  for (int j = 1; j + 1 < NT; j += 2) {
    SBAR(); qkt(pB0, pB1, K_lds + SHM_K, qr, r32, hi);
    finishSM(pA0, pA1, alA, l_reg, pa0, pa1, pa2, pa3); SBAR();
    SLOAD(SO, (j + 2) * KVBLK); SBAR();
    pv_d0(o, vb0, pa0, pa1, pa2, pa3); partialSM(pB0, pB1, m_reg, mnB, alB);
    __syncthreads(); SWAIT(); SWRITE(0, SE);
    RESC(alB); __syncthreads();
    SBAR(); qkt(pA0, pA1, K_lds, qr, r32, hi);
    finishSM(pB0, pB1, alB, l_reg, pa0, pa1, pa2, pa3); SBAR();
    if (j + 3 < NT) SLOAD(SE, (j + 3) * KVBLK); SBAR();
    pv_d0(o, vb0 + (int)SHM_V, pa0, pa1, pa2, pa3); partialSM(pA0, pA1, m_reg, mnA, alA);
    __syncthreads(); SWAIT(); SWRITE(1, SO);
    RESC(alA); __syncthreads();
  }
  SBAR(); qkt(pB0, pB1, K_lds + SHM_K, qr, r32, hi);
  finishSM(pA0, pA1, alA, l_reg, pa0, pa1, pa2, pa3); SBAR();
  pv_d0(o, vb0, pa0, pa1, pa2, pa3); partialSM(pB0, pB1, m_reg, mnB, alB);
  __syncthreads(); RESC(alB);
  finishSM(pB0, pB1, alB, l_reg, pa0, pa1, pa2, pa3); SBAR();
  pv_d0(o, vb0 + (int)SHM_V, pa0, pa1, pa2, pa3);
  if (hi == 0) li_l[r32] = l_reg; asm volatile("s_waitcnt lgkmcnt(0)" ::: "memory");
  float rli[16];
#pragma unroll
  for (int r = 0; r < 16; ++r) rli[r] = __builtin_amdgcn_rcpf(li_l[crow(r, hi)]);
  bf16_t* Ow = O + (size_t)(q0row + wid * QBLK) * 1024 + h * 64;
#pragma unroll
  for (int r = 0; r < 16; ++r) { const int orow = crow(r, hi);
#pragma unroll
    for (int d0 = 0; d0 < 2; ++d0) Ow[(size_t)orow * 1024 + d0 * 32 + r32] = (bf16_t)f2bf(o[d0][r] * rli[r]); }
  asm volatile("s_waitcnt vmcnt(0)" ::: "memory");
  __syncthreads();
#undef SLOAD
#undef SWRITE
#undef SWAIT
#undef RESC
}
#undef KSWZ
#undef SBAR
}

__device__ __forceinline__ void phase_attn_fast(const Ctx& C) {
    unsigned char* ws = C.a->ws; const bf16_t* Q = (const bf16_t*)(ws + WS_SCR + S_Q); const bf16_t* KV = (const bf16_t*)(ws + WS_SCR + S_KV);
    const bf16_t* KPE = (const bf16_t*)(ws + WS_SCR + S_KPE); bf16_t* O = (bf16_t*)(ws + WS_SCR + S_O); const float* ROPE = (const float*)(ws + WS_ROPE);
    char* lds = (char*)(unsigned char*)C.lds;
    const int bx = blockIdx.x, G = gridDim.x; const int vcu = (G % 8 == 0) ? (bx % 8) * (G / 8) + bx / 8 : bx;
    for (int u = vcu; u < 1024; u += G) {
        int q0, k0, seq, h, rt;
        if (u < 512) { const int bh = u >> 4, qb = u & 15, b = bh >> 4; h = bh & 15; q0 = NPR + b * 4096 + qb * 256; k0 = NPR + b * 4608; seq = 4608; rt = qb * 256; }
        else { const int v = u - 512, b = v >> 4; h = v & 15; q0 = b * 256; k0 = b * 256; seq = 256; rt = -1; }
        att::attn_unit(Q, KV, KPE, O, ROPE, q0, k0, seq, h, rt, lds);
    }
}
constexpr int SB = 16, OPS_STRIDE = 260, SCAN_LDS_PER_WAVE = SB * OPS_STRIDE * 4;

__device__ __forceinline__ void scan_item2(const Ctx& C, int row_first, int T, int h, int dir, int init, const float* initp, bool hasv, bf16_t* yout, float* endp, float* bon) {
    unsigned char* ws = C.a->ws; const float* const* in = C.a->in;
    const bf16_t* Rb = (const bf16_t*)(ws + WS_H + R_R); const bf16_t* Kb = (const bf16_t*)(ws + WS_H + R_K); const bf16_t* Vb = (const bf16_t*)(ws + WS_H + R_V);
    const bf16_t* T2 = (const bf16_t*)(ws + WS_H + R_T2);
    const bf16_t* W2T = (const bf16_t*)(ws + WS_W + W_RW + W_RW_W2T); const bf16_t* A2T = (const bf16_t*)(ws + WS_W + W_RW + W_RW_A2T);
    LAS float* opb = (LAS float*)(C.lds + C.wave * SCAN_LDS_PER_WAVE);
    const int lane = C.lane, ks = lane & 3, vg = lane >> 2, st = lane & 15, fq = lane >> 4;
    const int step_dir = dir == 0 ? 1 : -1; const int row_s0 = dir == 0 ? row_first : row_first + T - 1;
    float S[4][16];
#pragma unroll
    for (int i = 0; i < 4; ++i)
#pragma unroll
        for (int j = 0; j < 16; ++j) S[i][j] = (init == 1) ? ((4 * vg + i == 16 * ks + j) ? 1.f : 0.f) : 0.f;
    if (init == 2) {
#pragma unroll
        for (int i = 0; i < 4; ++i)
#pragma unroll
            for (int q = 0; q < 4; ++q) { const f32x4 v = *(const f32x4*)(initp + (4 * vg + i) * 64 + 16 * ks + 4 * q); S[i][4 * q] = v.x; S[i][4 * q + 1] = v.y; S[i][4 * q + 2] = v.z; S[i][4 * q + 3] = v.w; }
    }
    const bf16_t* rp = Rb + (size_t)row_s0 * DM + h * 64 + 16 * ks; const bf16_t* vp = Vb + (size_t)row_s0 * DM + h * 64 + 4 * vg;
    const ptrdiff_t rstep = (ptrdiff_t)step_dir * DM;
    u32x4 rc0 = *(const u32x4*)rp, rc1 = *(const u32x4*)(rp + 8); u32x2 vc = *(const u32x2*)vp;
    for (int s0 = 0; s0 < T; s0 += SB) {
        {
            const int rowS = row_s0 + (s0 + st) * step_dir;
            const bf16_t* t2r = T2 + (size_t)rowS * 256 + dir * 64 + 8 * fq;
            const bf16x8 bw0 = *(const bf16x8*)(t2r), bw1 = *(const bf16x8*)(t2r + 32), ba0 = *(const bf16x8*)(t2r + 128), ba1 = *(const bf16x8*)(t2r + 160);
            f32x4 accw[4], acca[4];
#pragma unroll
            for (int n = 0; n < 4; ++n) {
                const size_t wrow = ((size_t)(dir * 1024 + h * 64 + 16 * n + st)) * 64 + 8 * fq;
                accw[n] = __builtin_amdgcn_mfma_f32_16x16x32_bf16(*(const bf16x8*)(W2T + wrow), bw0, (f32x4){0.f, 0.f, 0.f, 0.f}, 0, 0, 0);
                accw[n] = __builtin_amdgcn_mfma_f32_16x16x32_bf16(*(const bf16x8*)(W2T + wrow + 32), bw1, accw[n], 0, 0, 0);
                acca[n] = __builtin_amdgcn_mfma_f32_16x16x32_bf16(*(const bf16x8*)(A2T + wrow), ba0, (f32x4){0.f, 0.f, 0.f, 0.f}, 0, 0, 0);
                acca[n] = __builtin_amdgcn_mfma_f32_16x16x32_bf16(*(const bf16x8*)(A2T + wrow + 32), ba1, acca[n], 0, 0, 0);
            }
            f32x4 kv[4]; float ssq = 0.f;
#pragma unroll
            for (int n = 0; n < 4; ++n) { const int ch0 = h * 64 + 16 * n + 4 * fq; const u32x2 kw = *(const u32x2*)(Kb + (size_t)rowS * DM + ch0);
                kv[n] = (f32x4){bflo(kw.x), bfhi(kw.x), bflo(kw.y), bfhi(kw.y)};
                const f32x4 kkr = kv[n] * *(const f32x4*)(in[I_KK] + ch0); ssq += (kkr.x * kkr.x + kkr.y * kkr.y) + (kkr.z * kkr.z + kkr.w * kkr.w); }
            ssq += __shfl_xor(ssq, 16); ssq += __shfl_xor(ssq, 32);
            const float inv = 1.0f / fmaxf(sqrtf(ssq), 1e-12f);
            float bsum = 0.f;
            LAS float* o = opb + st * OPS_STRIDE + 4 * fq;
#pragma unroll
            for (int n = 0; n < 4; ++n) { const int ch0 = h * 64 + 16 * n + 4 * fq;
                const u32x2 rw = *(const u32x2*)(Rb + (size_t)rowS * DM + ch0); const f32x4 rr = (f32x4){bflo(rw.x), bfhi(rw.x), bflo(rw.y), bfhi(rw.y)};
                const f32x4 zw = accw[n] + *(const f32x4*)(in[I_W0] + dir * DM + ch0), za = acca[n] + *(const f32x4*)(in[I_A0] + dir * DM + ch0);
                f32x4 wv, av;
                wv.x = __expf(-0.6065306597126334f * sigmoidf_(zw.x)); wv.y = __expf(-0.6065306597126334f * sigmoidf_(zw.y)); wv.z = __expf(-0.6065306597126334f * sigmoidf_(zw.z)); wv.w = __expf(-0.6065306597126334f * sigmoidf_(zw.w));
                av.x = sigmoidf_(za.x); av.y = sigmoidf_(za.y); av.z = sigmoidf_(za.z); av.w = sigmoidf_(za.w);
                const f32x4 kk = kv[n] * *(const f32x4*)(in[I_KK] + ch0) * inv;
                const f32x4 kd = kv[n] * ((av - 1.0f) * *(const f32x4*)(in[I_KA] + ch0) + 1.0f);
                const f32x4 bt = rr * kd * *(const f32x4*)(in[I_RK] + ch0); bsum += (bt.x + bt.y) + (bt.z + bt.w);
                *(LAS f32x4*)(o + 16 * n) = -kk; *(LAS f32x4*)(o + 64 + 16 * n) = wv; *(LAS f32x4*)(o + 128 + 16 * n) = kk * av; *(LAS f32x4*)(o + 192 + 16 * n) = kd; }
            bsum += __shfl_xor(bsum, 16); bsum += __shfl_xor(bsum, 32);
            if (bon && fq == 0) bon[(size_t)rowS * 16 + h] = bsum;
        }
        asm volatile("s_waitcnt lgkmcnt(0)" ::: "memory");
#pragma unroll 1
        for (int s = 0; s < SB; ++s) {
            const int sg = s0 + s;
            const int nx = (sg + 1 < T) ? 1 : 0;
            const bf16_t* rpn = rp + (ptrdiff_t)(sg + nx) * rstep; const bf16_t* vpn = vp + (ptrdiff_t)(sg + nx) * rstep;
            const u32x4 rn0 = *(const u32x4*)rpn, rn1 = *(const u32x4*)(rpn + 8); const u32x2 vn = *(const u32x2*)vpn;
            const LAS float* o = opb + s * OPS_STRIDE + 16 * ks;
            float av[16], wv[16], bv[16], kv[16], rv[16];
#pragma unroll
            for (int q = 0; q < 4; ++q) {
                const f32x4 x0 = *(const LAS f32x4*)(o + 4 * q), x1 = *(const LAS f32x4*)(o + 64 + 4 * q), x2 = *(const LAS f32x4*)(o + 128 + 4 * q), x3 = *(const LAS f32x4*)(o + 192 + 4 * q);
                av[4 * q] = x0.x; av[4 * q + 1] = x0.y; av[4 * q + 2] = x0.z; av[4 * q + 3] = x0.w;
                wv[4 * q] = x1.x; wv[4 * q + 1] = x1.y; wv[4 * q + 2] = x1.z; wv[4 * q + 3] = x1.w;
                bv[4 * q] = x2.x; bv[4 * q + 1] = x2.y; bv[4 * q + 2] = x2.z; bv[4 * q + 3] = x2.w;
                kv[4 * q] = x3.x; kv[4 * q + 1] = x3.y; kv[4 * q + 2] = x3.z; kv[4 * q + 3] = x3.w;
            }
            { const unsigned rw[8] = {rc0.x, rc0.y, rc0.z, rc0.w, rc1.x, rc1.y, rc1.z, rc1.w};
#pragma unroll
              for (int q = 0; q < 8; ++q) { rv[2 * q] = bflo(rw[q]); rv[2 * q + 1] = bfhi(rw[q]); } }
            float vv[4] = {bflo(vc.x), bfhi(vc.x), bflo(vc.y), bfhi(vc.y)};
            if (!hasv) { vv[0] = 0.f; vv[1] = 0.f; vv[2] = 0.f; vv[3] = 0.f; }
            float y[4];
#pragma unroll
            for (int i = 0; i < 4; ++i) {
                float sa = 0.f;
#pragma unroll
                for (int j = 0; j < 16; ++j) sa = fmaf(S[i][j], av[j], sa);
                sa += dpp_x1(sa); sa += dpp_x2(sa);
                float yy = 0.f;
#pragma unroll
                for (int j = 0; j < 16; ++j) { S[i][j] = fmaf(S[i][j], wv[j], fmaf(sa, bv[j], vv[i] * kv[j])); yy = fmaf(S[i][j], rv[j], yy); }
                yy += dpp_x1(yy); yy += dpp_x2(yy); y[i] = yy;
            }
            const float yo = ks == 0 ? y[0] : ks == 1 ? y[1] : ks == 2 ? y[2] : y[3];
            yout[(size_t)(row_s0 + sg * step_dir) * DM + h * 64 + lane] = (bf16_t)f2bf(yo);
            rc0 = rn0; rc1 = rn1; vc = vn;
        }
        asm volatile("s_waitcnt lgkmcnt(0)" ::: "memory");
    }
    if (endp) {
#pragma unroll
        for (int i = 0; i < 4; ++i)
#pragma unroll
            for (int q = 0; q < 4; ++q) *(f32x4*)(endp + (4 * vg + i) * 64 + 16 * ks + 4 * q) = (f32x4){S[i][4 * q], S[i][4 * q + 1], S[i][4 * q + 2], S[i][4 * q + 3]};
    }
}
__device__ __forceinline__ void phase_rw_scan_seq2(const Ctx& C) {
    unsigned char* ws = C.a->ws; bf16_t* Y = (bf16_t*)(ws + WS_H + R_Y); float* BON = (float*)(ws + WS_H + R_BON);
    for (int it = C.gw; it < 1088; it += C.NGW) {
        int row0, T, h, dir, init; const float* ip; float* ep;
        if (it < 64) { const int b = it >> 5; h = (it >> 1) & 15; dir = it & 1; row0 = NPR + b * 4096; T = 4096; init = 2; ip = C.a->in[I_SWKV] + ((size_t)(b * 2 + dir) * 16 + h) * 4096; ep = nullptr; }
        else { const int q = it - 64, b = q >> 5; h = (q >> 1) & 15; dir = q & 1; row0 = b * 256; T = 256; init = 0; ip = nullptr; ep = C.a->out + OUT_WKV + ((size_t)(b * 2 + dir) * 16 + h) * 4096; }
        scan_item2(C, row0, T, h, dir, init, ip, true, Y + (size_t)dir * MROWS * DM, ep, BON + (size_t)dir * MROWS * 16);
    }
}
constexpr int NCH = 8, CHL = 512;
__device__ __forceinline__ void phase_rw_scan_chunk(const Ctx& C) {
    unsigned char* ws = C.a->ws; bf16_t* Y = (bf16_t*)(ws + WS_H + R_Y); float* BON = (float*)(ws + WS_H + R_BON); bf16_t* QT = (bf16_t*)(ws + WS_H + R_QT); float* EP = (float*)(ws + WS_H + R_EP);
    const int nblk = gridDim.x;
    for (int base = blockIdx.x; base < 256; base += nblk) {
        const int slot = C.wave & 3, idx = base * 4 + slot;
        if (C.wave < 4) {
            if (idx < 960) {
                int u, c, kind; if (idx < 512) { u = idx >> 3; c = idx & 7; kind = 0; } else { const int x = idx - 512; u = x / 7; c = 1 + (x - u * 7); kind = 1; }
                const int b = u >> 5, h = (u >> 1) & 15, dir = u & 1;
                const int row_first = NPR + b * 4096 + (dir == 0 ? c * CHL : 4096 - (c + 1) * CHL);
                float* ep = EP + ((size_t)(u * NCH + c) * 2 + kind) * 4096;
                if (kind == 0) scan_item2(C, row_first, CHL, h, dir, c == 0 ? 2 : 0, C.a->in[I_SWKV] + ((size_t)(b * 2 + dir) * 16 + h) * 4096, true, Y + (size_t)dir * MROWS * DM, ep, BON + (size_t)dir * MROWS * 16);
                else scan_item2(C, row_first, CHL, h, dir, 1, nullptr, false, QT + (size_t)dir * 8192 * DM - (size_t)NPR * DM, ep, nullptr);
            }
        } else {
            const int b = idx >> 5, h = (idx >> 1) & 15, dir = idx & 1;
            scan_item2(C, b * 256, 256, h, dir, 0, nullptr, true, Y + (size_t)dir * MROWS * DM, C.a->out + OUT_WKV + ((size_t)(b * 2 + dir) * 16 + h) * 4096, BON + (size_t)dir * MROWS * 16);
        }
    }
}
__device__ __forceinline__ void phase_rw_pass2(const Ctx& C) {
    if (C.wave != 0) return;
    unsigned char* ws = C.a->ws; const float* EP = (const float*)(ws + WS_H + R_EP); float* SS = (float*)(ws + WS_H + R_SS);
    const int vl = C.lane & 15, q = C.lane >> 4;
    for (int item = blockIdx.x; item < 256; item += gridDim.x) {
        const int u = item >> 2, vs = item & 3, v = 16 * vs + vl;
        f32x4 acc[4];
#pragma unroll
        for (int ti = 0; ti < 4; ++ti) { acc[ti] = *(const f32x4*)(EP + ((size_t)(u * NCH + 0) * 2 + 0) * 4096 + v * 64 + 16 * ti + 4 * q); *(f32x4*)(SS + (size_t)(u * NCH + 1) * 4096 + v * 64 + 16 * ti + 4 * q) = acc[ti]; }
#pragma unroll 1
        for (int c = 1; c < NCH - 1; ++c) {
            const float* LE = EP + ((size_t)(u * NCH + c) * 2 + 0) * 4096; const float* PE = EP + ((size_t)(u * NCH + c) * 2 + 1) * 4096;
            f32x4 nw[4];
#pragma unroll
            for (int to = 0; to < 4; ++to) nw[to] = *(const f32x4*)(LE + v * 64 + 16 * to + 4 * q);
#pragma unroll
            for (int ti = 0; ti < 4; ++ti)
#pragma unroll
                for (int r = 0; r < 4; ++r) { const float* prow = PE + (16 * ti + 4 * q + r) * 64 + vl;
#pragma unroll
                    for (int to = 0; to < 4; ++to) nw[to] = __builtin_amdgcn_mfma_f32_16x16x4f32(prow[16 * to], acc[ti][r], nw[to], 0, 0, 0); }
#pragma unroll
            for (int ti = 0; ti < 4; ++ti) { acc[ti] = nw[ti]; *(f32x4*)(SS + (size_t)(u * NCH + c + 1) * 4096 + v * 64 + 16 * ti + 4 * q) = acc[ti]; }
        }
    }
}
__device__ __forceinline__ void phase_rw_post2(const Ctx& C) {
    unsigned char* ws = C.a->ws; bf16_t* Y0 = (bf16_t*)(ws + WS_H + R_Y); const bf16_t* Y1 = Y0 + (size_t)MROWS * DM; const float* BON = (const float*)(ws + WS_H + R_BON);
    const bf16_t* Vb = (const bf16_t*)(ws + WS_H + R_V); const bf16_t* G = (const bf16_t*)(ws + WS_H + R_G); const bf16_t* QT = (const bf16_t*)(ws + WS_H + R_QT); const float* SS = (const float*)(ws + WS_H + R_SS);
    const float* lg = C.a->in[I_LNXG]; const float* lb = C.a->in[I_LNXB]; const int tl = C.lane & 15, qd = C.lane >> 4;
    for (int it = C.gw; it < (MROWS / 16) * 16; it += C.NGW) {
        const int rb = it >> 4, h = it & 15, row0 = rb * 16, row = row0 + tl;
        f32x4 y[4];
#pragma unroll
        for (int vt = 0; vt < 4; ++vt) { const size_t e = (size_t)row * DM + h * 64 + 16 * vt + 4 * qd; const u32x2 a = *(const u32x2*)(Y0 + e), b = *(const u32x2*)(Y1 + e);
            y[vt] = (f32x4){bflo(a.x) + bflo(b.x), bfhi(a.x) + bfhi(b.x), bflo(a.y) + bflo(b.y), bfhi(a.y) + bfhi(b.y)}; }
        if (row0 >= NPR) {
            const int bb = (row0 - NPR) >> 12, t0 = (row0 - NPR) & 4095;
#pragma unroll
            for (int d = 0; d < 2; ++d) {
                const int c = d == 0 ? (t0 >> 9) : ((4095 - t0) >> 9);
                if (c > 0) {
                    const int u = (bb * 16 + h) * 2 + d; const float* Sst = SS + (size_t)(u * NCH + c) * 4096;
                    const bf16_t* qrow = QT + (size_t)d * 8192 * DM + (size_t)(row - NPR) * DM + h * 64 + 8 * qd;
                    const bf16x8 b0 = *(const bf16x8*)qrow, b1 = *(const bf16x8*)(qrow + 32);
#pragma unroll
                    for (int vt = 0; vt < 4; ++vt) { const float* sr = Sst + (16 * vt + tl) * 64 + 8 * qd;
                        const f32x4 s0 = *(const f32x4*)sr, s1 = *(const f32x4*)(sr + 4), s2 = *(const f32x4*)(sr + 32), s3 = *(const f32x4*)(sr + 36);
                        u32x4 w0 = {pk2(s0.x, s0.y), pk2(s0.z, s0.w), pk2(s1.x, s1.y), pk2(s1.z, s1.w)}, w1 = {pk2(s2.x, s2.y), pk2(s2.z, s2.w), pk2(s3.x, s3.y), pk2(s3.z, s3.w)};
                        f32x4 acc = __builtin_amdgcn_mfma_f32_16x16x32_bf16(*reinterpret_cast<bf16x8*>(&w0), b0, (f32x4){0.f, 0.f, 0.f, 0.f}, 0, 0, 0);
                        acc = __builtin_amdgcn_mfma_f32_16x16x32_bf16(*reinterpret_cast<bf16x8*>(&w1), b1, acc, 0, 0, 0);
                        y[vt] = y[vt] + acc; }
                }
            }
        }
        float s = 0.f;
#pragma unroll
        for (int vt = 0; vt < 4; ++vt) s += (y[vt].x + y[vt].y) + (y[vt].z + y[vt].w);
        s += __shfl_xor(s, 16); s += __shfl_xor(s, 32);
        const float mean = s * (1.f / 64.f); float q2 = 0.f;
#pragma unroll
        for (int vt = 0; vt < 4; ++vt) { y[vt] = y[vt] - mean; q2 += (y[vt].x * y[vt].x + y[vt].y * y[vt].y) + (y[vt].z * y[vt].z + y[vt].w * y[vt].w); }
        q2 += __shfl_xor(q2, 16); q2 += __shfl_xor(q2, 32);
        const float rstd = 1.0f / sqrtf(q2 * (1.f / 64.f) + 64e-5f);
        const float bonus = BON[(size_t)row * 16 + h] + BON[(size_t)MROWS * 16 + (size_t)row * 16 + h];
#pragma unroll
        for (int vt = 0; vt < 4; ++vt) { const int ch0 = h * 64 + 16 * vt + 4 * qd; const size_t e = (size_t)row * DM + ch0;
            const u32x2 vw = *(const u32x2*)(Vb + e), gw2 = *(const u32x2*)(G + e);
            const f32x4 vv = (f32x4){bflo(vw.x), bfhi(vw.x), bflo(vw.y), bfhi(vw.y)}, gg = (f32x4){bflo(gw2.x), bfhi(gw2.x), bflo(gw2.y), bfhi(gw2.y)};
            const f32x4 o = (y[vt] * rstd * *(const f32x4*)(lg + ch0) + *(const f32x4*)(lb + ch0) + vv * bonus) * gg;
            u32x2 w; w.x = pk2(o.x, o.y); w.y = pk2(o.z, o.w); *(u32x2*)(Y0 + e) = w; }
    }
}
#ifndef MK_MULTI
#define MK_MULTI 0
#endif
constexpr int NPHASES = 38;

__global__ void __launch_bounds__(NWAVES * 64, 2) mega_fwd(Args args) {
    extern __shared__ __attribute__((aligned(16))) unsigned char lds_raw[];
    Ctx C; C.a = &args; C.lds = (LAS unsigned char*)lds_raw;
    C.tid = threadIdx.x; C.lane = C.tid & 63; C.wave = __builtin_amdgcn_readfirstlane(C.tid >> 6);
    C.gw = blockIdx.x * NWAVES + C.wave; C.NGW = gridDim.x * NWAVES;
    volatile LAS unsigned* MISC = (volatile LAS unsigned*)(C.lds + MISC_OFF);
    if (C.tid < 32) MISC[C.tid] = 0u;
    __syncthreads();
    unsigned char* ws = args.ws;
    unsigned* ctl = (unsigned*)(ws + WS_CTL);
    XcdBarrier bar; bar.bar = ctl + CW_BAR; bar.x = 0; bar.st = MISC + 8;
    if (!MK_MULTI) bar = xcd_barrier_post(ctl + CW_BAR, MISC + 8);
    const int lo = args.ph_lo, hi = args.ph_hi; int ph = 0;
#ifndef DUP_PHASE
#define DUP_PHASE -1
#endif
#define PHASE(body) do { if (ph >= lo && ph < hi) { if (ph == DUP_PHASE) { body; xcd_barrier(bar); } body; if (!MK_MULTI && ph + 1 < hi) xcd_barrier(bar); else __syncthreads(); } ++ph; } while (0)

    bf16_t* WB = (bf16_t*)(ws + WS_W); float* X = (float*)(ws + WS_X); const bf16_t* H = (const bf16_t*)(ws + WS_H); const float* MOD = (const float*)(ws + WS_MOD);
    PHASE(phase0(C));
    PHASE(phase_init(C));
#define DO_LAYER(layer) do { \
        const int kind = layer % 3, j = layer / 3; \
        if (kind == 0) { \
            unsigned char* wm = (unsigned char*)WB + W_MLA + j * W_MLA_STRIDE; \
            PHASE(gemm_fast(C, ASelPlain{H}, 1024, (const bf16_t*)(wm + W_MLA_1), 1024, MROWS, 768, 1024, EpiF32{(float*)(ws + WS_SCR + S_R1), 768})); \
            PHASE(phase_mla_norm(C, j)); \
            PHASE(gemm_fast(C, ASelPlain{(const bf16_t*)(ws + WS_SCR + S_QA)}, 384, (const bf16_t*)(wm + W_MLA_QB), 384, MROWS, 1536, 384, EpiBf16{(bf16_t*)(ws + WS_SCR + S_Q), 1536}); \
                  gemm_fast(C, ASelPlain{(const bf16_t*)(ws + WS_SCR + S_CKV)}, 256, (const bf16_t*)(wm + W_MLA_KVB), 256, KVR, 2048, 256, EpiBf16{(bf16_t*)(ws + WS_SCR + S_KV), 2048})); \
            PHASE(phase_attn_fast(C)); \
            PHASE(gemm_fast(C, ASelPlain{(const bf16_t*)(ws + WS_SCR + S_O)}, 1024, (const bf16_t*)(wm + W_MLA_O), 1024, MROWS, 1024, 1024, EpiResid{X, MOD, layer, 2, nullptr})); \
        } else if (kind == 1) { \
            unsigned char* wr = (unsigned char*)WB + W_RW; const bf16_t* XA = (const bf16_t*)(ws + WS_H + R_XA); \
            PHASE(phase_rw_prep(C, layer, 0)); \
            PHASE(gemm_fast(C, ASelShift{XA, 10, (size_t)MROWS * DM}, 1024, (const bf16_t*)(wr + W_RW_1), 1024, MROWS, 3072, 1024, EpiRwA{(bf16_t*)(ws + WS_H + R_R)})); \
            PHASE(phase_rw_prep(C, layer, 1)); \
            PHASE(gemm_fast(C, ASelShift{XA, 8, (size_t)MROWS * DM}, 1024, (const bf16_t*)(wr + W_RW_1) + (size_t)3072 * 1024, 1024, MROWS, 768, 1024, EpiRwB{(bf16_t*)(ws + WS_H + R_T2), (bf16_t*)(ws + WS_H + R_SG)})); \
            PHASE(phase_rw_scan_chunk(C)); \
            PHASE(gemm_fast(C, ASelPlain{(const bf16_t*)(ws + WS_H + R_SG)}, 256, (const bf16_t*)(wr + W_RW_G2T), 256, MROWS, 1024, 256, EpiBf16{(bf16_t*)(ws + WS_H + R_G), 1024}); phase_rw_pass2(C)); \
            PHASE(phase_rw_post2(C)); \
            PHASE(gemm_fast(C, ASelPlain{(const bf16_t*)(ws + WS_H + R_Y)}, 1024, (const bf16_t*)(wr + W_RW_O), 1024, MROWS, 1024, 1024, EpiResid{X, MOD, layer, 2, nullptr})); \
        } else { \
            PHASE(phase_pool_prep(C, layer)); \
            PHASE(gemm_fast(C, ASelShift{(const bf16_t*)(ws + WS_SCR + S_POOL), 8, (size_t)256}, 1024, (const bf16_t*)((unsigned char*)WB + W_POOL), 256, MROWS, 1024, 256, EpiResid{X, MOD, layer, 2, args.in[I_POOLS]})); \
        } \
        PHASE(phase_ln(C, layer, 0, layer, 3, false)); \
        PHASE(gemm_fast(C, ASelPlain{H}, 1024, (const bf16_t*)((unsigned char*)WB + layer * W_FFN_STRIDE + W_FFN_GU), 1024, MROWS, 5632, 1024, EpiSwiglu{(bf16_t*)(ws + WS_SCR + S_ACT)})); \
        PHASE(gemm_fast(C, ASelPlain{(const bf16_t*)(ws + WS_SCR + S_ACT)}, 2816, (const bf16_t*)((unsigned char*)WB + layer * W_FFN_STRIDE + W_FFN_D), 2816, MROWS, 1024, 2816, EpiResid{X, MOD, layer, 5, nullptr})); \
        PHASE(phase_ln(C, layer, 1, layer + 1, (layer == 2) ? 0 : -1, layer == 3)); \
     \
} while (0)
    DO_LAYER(0); DO_LAYER(1); DO_LAYER(2); DO_LAYER(3);
    if (!MK_MULTI && xb_ld(ctl + CW_BAR + XB_TMO) != 0u && blockIdx.x == 0 && C.tid == 0) args.out[0] = __builtin_nanf("");
}

extern "C" void kernel_launch(void* const* d_in, const int* in_sizes, int n_in, void* d_out, int out_size, void* d_ws, size_t ws_size, hipStream_t stream) {
    static int grid = 0;
    if (grid == 0) {
        int dev = 0, cus = 0, per_cu = 0;
        if (hipGetDevice(&dev) != hipSuccess || hipDeviceGetAttribute(&cus, hipDeviceAttributeMultiprocessorCount, dev) != hipSuccess) grid = -1;
        else if (hipFuncSetAttribute((const void*)mega_fwd, hipFuncAttributeMaxDynamicSharedMemorySize, LDS_BYTES) != hipSuccess) grid = -1;
        else {
            if (hipOccupancyMaxActiveBlocksPerMultiprocessor(&per_cu, (const void*)mega_fwd, NWAVES * 64, LDS_BYTES) != hipSuccess || per_cu < 1) { fprintf(stderr, "occupancy query: %d\n", per_cu); grid = -1; }
            else grid = cus;
            (void)hipGetLastError();
        }
        if (n_in != 41 || out_size != OUT_TOTAL || ws_size < WS_END) { fprintf(stderr, "kernel_launch: unexpected n_in %d out %d ws %zu\n", n_in, out_size, ws_size); grid = -2; }
    }
    if (grid == -2) { (void)hipMemsetAsync(d_out, 0xFF, (size_t)out_size * 4, stream); return; }
    if (grid < 0) return;
    (void)hipMemsetAsync((char*)d_ws + WS_CTL, 0, CTL_ZERO_BYTES, stream);
    Args a{};
    for (int i = 0; i < 41; ++i) a.in[i] = (const float*)d_in[i];
    a.out = (float*)d_out; a.ws = (unsigned char*)d_ws;
#if MK_MULTI
    for (int p = 0; p < NPHASES; ++p) { a.ph_lo = p; a.ph_hi = p + 1; hipLaunchKernelGGL(mega_fwd, dim3(grid), dim3(NWAVES * 64), LDS_BYTES, stream, a); }
#else
    a.ph_lo = 0; a.ph_hi = NPHASES;
    void* kargs[] = {&a};
    hipError_t e = hipLaunchCooperativeKernel((const void*)mega_fwd, dim3(grid), dim3(NWAVES * 64), kargs, LDS_BYTES, stream);
    if (e != hipSuccess) fprintf(stderr, "cooperative launch failed: %s (grid %d)\n", hipGetErrorString(e), grid);
#endif
}
```
